# Optimizing an MI355X kernel written in HIP

```python
import math
import jax
import jax.numpy as jnp
from jax import lax
import numpy as np

D_MODEL = 1024
BATCH = 8
SEQ = 4096
DEPTH = 2

EPS = 1e-6
POOL_WINDOWS = (2, 4, 8, 16)
POOL_GROUP = D_MODEL // 16
POOL_WIDTH = POOL_GROUP * len(POOL_WINDOWS)
M_HEADS = 4
M_HEAD_DIM = D_MODEL // 16
M_WIDTH = M_HEADS * M_HEAD_DIM
M_CONV = 4
M_CHUNK = 64
D_HEADS = 4
D_HEAD_DIM = D_MODEL // 16
D_V_DIM = 2 * D_HEAD_DIM
D_QK_WIDTH = D_HEADS * 2 * D_HEAD_DIM
D_WIDTH = D_HEADS * D_V_DIM
Q_BLOCK = 128
ROPE_THETA = 10000.0
N_BRANCH = 3
D_FF = ((8 * D_MODEL // 3 + 127) // 128) * 128
IN_SPLITS = (POOL_WIDTH, M_WIDTH, M_WIDTH, M_WIDTH, M_WIDTH, 2 * M_HEADS, D_QK_WIDTH, D_QK_WIDTH, D_WIDTH, N_BRANCH * D_MODEL)
N_IN = sum(IN_SPLITS)

kernel_name = "hybrid_pool_mlstm_diffattn_macaron"


def rmsnorm(x, g):
    xf = x.astype(jnp.float32)
    y = xf * lax.rsqrt(jnp.mean(xf * xf, axis=-1, keepdims=True) + EPS)
    return (y * g).astype(x.dtype)


def swiglu(x, w13, w2):
    g, u = jnp.split(x @ w13, 2, axis=-1)
    return (jax.nn.silu(g) * u) @ w2


def rope_tables(positions, dim):
    inv = 1.0 / (ROPE_THETA ** (jnp.arange(0, dim, 2, dtype=jnp.float32) / dim))
    ang = positions.astype(jnp.float32)[..., None] * inv
    return jnp.cos(ang)[:, :, None, :], jnp.sin(ang)[:, :, None, :]


def apply_rope(x, cos, sin):
    x1, x2 = jnp.split(x.astype(jnp.float32), 2, axis=-1)
    return jnp.concatenate([x1 * cos - x2 * sin, x2 * cos + x1 * sin], axis=-1).astype(x.dtype)


def pool_mixer(u, w_grp, scale):
    B, S, _ = u.shape
    uf = u.astype(jnp.float32)
    cs = jnp.concatenate([jnp.zeros((B, 1, POOL_WIDTH), jnp.float32), jnp.cumsum(uf, axis=1)], axis=1)
    t = jnp.arange(S)
    outs = []
    for g, w in enumerate(POOL_WINDOWS):
        c = cs[:, :, g * POOL_GROUP:(g + 1) * POOL_GROUP]
        lo = jnp.maximum(t + 1 - w, 0)
        win_sum = c[:, 1:] - c[:, lo]
        cnt = jnp.minimum(t + 1, w).astype(jnp.float32)[None, :, None]
        outs.append(win_sum / cnt - uf[:, :, g * POOL_GROUP:(g + 1) * POOL_GROUP])
    pooled = jnp.stack(outs, axis=2).astype(u.dtype)
    mixed = jnp.einsum('bsgc,gcd->bsgd', pooled, w_grp)
    return mixed.reshape(B, S, POOL_WIDTH) * scale


def causal_depthwise_conv(x, w, b):
    C = x.shape[-1]
    y = lax.conv_general_dilated(x, w[:, None, :], window_strides=(1,), padding=((M_CONV - 1, 0),),
                                 dimension_numbers=('NWC', 'WIO', 'NWC'), feature_group_count=C)
    return y + b


def mlstm_chunkwise(q, k, v, i_pre, f_pre):
    B, H, S, dh = q.shape
    L = M_CHUNK
    NC = S // L
    qf = q.astype(jnp.float32)
    kf = k.astype(jnp.float32) / math.sqrt(dh)
    vf = v.astype(jnp.float32)
    logf = jax.nn.log_sigmoid(f_pre)

    def chunks(a):
        return jnp.moveaxis(a.reshape((B, H, NC, L) + a.shape[3:]), 2, 0)

    causal = jnp.tril(jnp.ones((L, L), dtype=bool))

    def step(carry, xs):
        Cm, nv, m = carry
        qc, kc, vc, ic, lfc = xs
        bcum = jnp.cumsum(lfc, axis=-1)
        dmat = bcum[..., :, None] - bcum[..., None, :] + ic[..., None, :]
        dmat = jnp.where(causal, dmat, -jnp.inf)
        inter = bcum + m[..., None]
        m_t = jnp.maximum(inter, jnp.max(dmat, axis=-1))
        w_intra = jnp.exp(dmat - m_t[..., None])
        w_inter = jnp.exp(inter - m_t)
        sc = jnp.einsum('bhtd,bhsd->bhts', qc, kc) * w_intra
        num = jnp.einsum('bhts,bhsd->bhtd', sc, vc) + w_inter[..., None] * jnp.einsum('bhed,bhtd->bhte', Cm, qc)
        den = jnp.sum(sc, axis=-1) + w_inter * jnp.einsum('bhd,bhtd->bht', nv, qc)
        h = num / jnp.maximum(jnp.abs(den), jnp.exp(-m_t))[..., None]
        b_last = bcum[..., -1]
        g = b_last[..., None] - bcum + ic
        m_new = jnp.maximum(b_last + m, jnp.max(g, axis=-1))
        decay = jnp.exp(b_last + m - m_new)
        wk = jnp.exp(g - m_new[..., None])
        C_new = decay[..., None, None] * Cm + jnp.einsum('bhs,bhse,bhsd->bhed', wk, vc, kc)
        n_new = decay[..., None] * nv + jnp.einsum('bhs,bhsd->bhd', wk, kc)
        return (C_new, n_new, m_new), h

    init = (jnp.zeros((B, H, dh, dh), jnp.float32), jnp.zeros((B, H, dh), jnp.float32), jnp.zeros((B, H), jnp.float32))
    _, hs = lax.scan(step, init, (chunks(qf), chunks(kf), chunks(vf), chunks(i_pre), chunks(logf)))
    return jnp.moveaxis(hs, 0, 2).reshape(B, H, S, dh)


def mlstm_branch(m_q, m_k, m_v, m_o, m_if, conv_w, conv_b, gate_b, norm_g):
    B, S, _ = m_q.shape
    qk = jax.nn.silu(causal_depthwise_conv(jnp.concatenate([m_q, m_k], axis=-1), conv_w, conv_b))
    q, k = jnp.split(qk, 2, axis=-1)

    def heads(a):
        return a.reshape(B, S, M_HEADS, M_HEAD_DIM).transpose(0, 2, 1, 3)

    gates = (m_if + gate_b).astype(jnp.float32).transpose(0, 2, 1)
    i_pre, f_pre = gates[:, :M_HEADS], gates[:, M_HEADS:]
    h = mlstm_chunkwise(heads(q), heads(k), heads(m_v), i_pre, f_pre)
    mu = jnp.mean(h, axis=-1, keepdims=True)
    var = jnp.mean(jnp.square(h - mu), axis=-1, keepdims=True)
    h = (h - mu) * lax.rsqrt(var + EPS)
    h = h.transpose(0, 2, 1, 3).reshape(B, S, M_WIDTH) * norm_g
    return (jax.nn.sigmoid(m_o.astype(jnp.float32)) * h).astype(m_q.dtype)


def diff_attention(q, k, v, lam, norm_g, lambda_init):
    B, S = q.shape[0], q.shape[1]
    qh = q.transpose(0, 2, 1, 3) * (D_HEAD_DIM ** -0.5)
    kh = k.transpose(0, 2, 1, 3)
    vh = v.transpose(0, 2, 1, 3)
    lamf = lam.astype(jnp.float32)
    lam_full = jnp.exp(jnp.sum(lamf[0] * lamf[1])) - jnp.exp(jnp.sum(lamf[2] * lamf[3])) + lambda_init
    NB = S // Q_BLOCK
    qb = qh.reshape(B, 2 * D_HEADS, NB, Q_BLOCK, D_HEAD_DIM).transpose(2, 0, 1, 3, 4)
    kpos = jnp.arange(S)

    def block(args):
        qblk, start = args
        s = jnp.einsum('bhqd,bhkd->bhqk', qblk, kh).astype(jnp.float32)
        qpos = start + jnp.arange(Q_BLOCK)
        s = jnp.where(kpos[None, :] <= qpos[:, None], s, -jnp.inf)
        p = jax.nn.softmax(s, axis=-1).reshape(B, D_HEADS, 2, Q_BLOCK, S)
        a = p[:, :, 0] - lam_full * p[:, :, 1]
        return jnp.einsum('bhqk,bhkd->bhqd', a.astype(vh.dtype), vh)

    out = lax.map(block, (qb, jnp.arange(NB, dtype=jnp.int32) * Q_BLOCK))
    out = out.transpose(1, 2, 0, 3, 4).reshape(B, D_HEADS, S, D_V_DIM).astype(jnp.float32)
    out = out * lax.rsqrt(jnp.mean(out * out, axis=-1, keepdims=True) + EPS) * norm_g
    out = out * (1.0 - lambda_init)
    return out.transpose(0, 2, 1, 3).reshape(B, S, D_WIDTH).astype(v.dtype)


def setup_inputs(seed: int = 0) -> dict:
    key = jax.random.key(seed)
    ks = jax.random.split(key, 24)
    f32 = jnp.float32
    L = DEPTH

    def nrm(k, shape, scale):
        return jax.random.normal(k, shape, f32) * scale

    def gain(k, shape):
        return 1.0 + 0.02 * jax.random.normal(k, shape, f32)

    f_bias = jnp.broadcast_to(jnp.linspace(3.0, 6.0, M_HEADS, dtype=f32), (L, M_HEADS))
    m_gate_b = jnp.concatenate([nrm(ks[10], (L, M_HEADS), 0.1), f_bias + nrm(ks[11], (L, M_HEADS), 0.1)], axis=-1)
    return {
        "x": jax.random.normal(ks[0], (BATCH, SEQ, D_MODEL), f32),
        "positions": jnp.broadcast_to(jnp.arange(SEQ, dtype=jnp.int32), (BATCH, SEQ)),
        "ffn1_norm": gain(ks[1], (L, D_MODEL)),
        "ffn1_w13": nrm(ks[2], (L, D_MODEL, 2 * D_FF), D_MODEL ** -0.5),
        "ffn1_w2": nrm(ks[3], (L, D_FF, D_MODEL), D_FF ** -0.5),
        "mix_norm": gain(ks[4], (L, D_MODEL)),
        "w_in": nrm(ks[5], (L, D_MODEL, N_IN), D_MODEL ** -0.5),
        "pool_w": nrm(ks[6], (L, len(POOL_WINDOWS), POOL_GROUP, POOL_GROUP), POOL_GROUP ** -0.5),
        "pool_scale": gain(ks[7], (L, POOL_WIDTH)),
        "m_conv_w": nrm(ks[8], (L, M_CONV, 2 * M_WIDTH), M_CONV ** -0.5),
        "m_conv_b": nrm(ks[9], (L, 2 * M_WIDTH), 0.01),
        "m_gate_b": m_gate_b,
        "m_norm": gain(ks[12], (L, M_WIDTH)),
        "d_lambda": nrm(ks[13], (L, 4, D_HEAD_DIM), 0.1),
        "d_norm": gain(ks[14], (L, D_V_DIM)),
        "p_a": nrm(ks[15], (L, POOL_WIDTH, D_MODEL), POOL_WIDTH ** -0.5),
        "p_b": nrm(ks[16], (L, M_WIDTH, D_MODEL), M_WIDTH ** -0.5),
        "p_c": nrm(ks[17], (L, D_WIDTH, D_MODEL), D_WIDTH ** -0.5),
        "w_out": nrm(ks[18], (L, D_MODEL, D_MODEL), D_MODEL ** -0.5),
        "ffn2_norm": gain(ks[19], (L, D_MODEL)),
        "ffn2_w13": nrm(ks[20], (L, D_MODEL, 2 * D_FF), D_MODEL ** -0.5),
        "ffn2_w2": nrm(ks[21], (L, D_FF, D_MODEL), D_FF ** -0.5),
        "final_norm": gain(ks[22], (D_MODEL,)),
    }


def reference(x, positions, ffn1_norm, ffn1_w13, ffn1_w2, mix_norm, w_in, pool_w, pool_scale, m_conv_w, m_conv_b, m_gate_b, m_norm, d_lambda, d_norm, p_a, p_b, p_c, w_out, ffn2_norm, ffn2_w13, ffn2_w2, final_norm):
    B, S, _ = x.shape
    cos, sin = rope_tables(positions, D_HEAD_DIM)
    split_at = np.cumsum(IN_SPLITS)[:-1].tolist()
    for l in range(DEPTH):
        lambda_init = 0.8 - 0.6 * math.exp(-0.3 * l)
        x = x + 0.5 * swiglu(rmsnorm(x, ffn1_norm[l]), ffn1_w13[l], ffn1_w2[l])
        h = rmsnorm(x, mix_norm[l])
        z = jnp.einsum('bsd,dn->bsn', h, w_in[l])
        (u_pool, m_q, m_k, m_v, m_o, m_if, d_q, d_k, d_v, gate_pre) = jnp.split(z, split_at, axis=-1)
        y_a = pool_mixer(u_pool, pool_w[l], pool_scale[l])
        y_b = mlstm_branch(m_q, m_k, m_v, m_o, m_if, m_conv_w[l], m_conv_b[l], m_gate_b[l], m_norm[l])
        dq = apply_rope(d_q.reshape(B, S, 2 * D_HEADS, D_HEAD_DIM), cos, sin)
        dk = apply_rope(d_k.reshape(B, S, 2 * D_HEADS, D_HEAD_DIM), cos, sin)
        y_c = diff_attention(dq, dk, d_v.reshape(B, S, D_HEADS, D_V_DIM), d_lambda[l], d_norm[l], lambda_init)
        g_a, g_b, g_c = jnp.split(jax.nn.sigmoid(gate_pre), N_BRANCH, axis=-1)
        merged = g_a * (y_a @ p_a[l]) + g_b * (y_b @ p_b[l]) + g_c * (y_c @ p_c[l])
        x = x + merged @ w_out[l]
        x = x + 0.5 * swiglu(rmsnorm(x, ffn2_norm[l]), ffn2_w13[l], ffn2_w2[l])
    return rmsnorm(x, final_norm)
```

```cpp
#include <hip/hip_runtime.h>
#include <cstdio>
#include <cstdint>
namespace pg8 {
#define PG8_LAS __attribute__((address_space(3)))
typedef unsigned short bf16_t;
typedef short bf16x8 __attribute__((ext_vector_type(8)));
typedef float f32x4 __attribute__((ext_vector_type(4)));
typedef unsigned u32x4 __attribute__((ext_vector_type(4)));
constexpr int BM = 256, BK = 64, HALF = 128, HTB = HALF * BK * 2  , STAGE_BYTES = 8 * HTB, NXCD = 8, WGM = 8;

__host__ __device__ __forceinline__ int lds_byte(int r, int c) { const int st = (r >> 4) * 2 + (c >> 5), rr = r & 15, cc = c & 31, ob = rr * 64 + cc * 2; return st * 1024 + (ob ^ (((ob >> 9) & 1) << 5)); }
__host__ __device__ __forceinline__ void stage_rc(int b, int& R, int& C) { const int st = b / 1024, sb = b % 1024, swz = sb ^ (((sb >> 9) & 1) << 5); R = (st >> 1) * 16 + swz / 64; C = (st & 1) * 32 + (swz % 64) / 2; }
__host__ __device__ __forceinline__ int perm32(int rho) { const int n = rho >> 4, i = rho & 15; return 8 * (i >> 2) + 4 * n + (i & 3); }

struct Unit { int pm, pn; };
struct Gemm { const bf16_t* A; const bf16_t* Bt; int M, N, K; };

struct StaticOrder {
    int nM, nN, nwg, G, c;
    __host__ __device__ void init(int M, int N, int G_, int c_) { nM = M / BM; nN = N / BM; nwg = nM * nN; G = G_; c = c_; }
    __host__ __device__ bool next(int i, Unit& u) const {
        const long L = (long)i * G + c; if (L >= nwg) return false;
        int wgid = (int)L; { const int q = nwg / NXCD, r = nwg % NXCD, xcd = wgid % NXCD, off = wgid / NXCD; wgid = (xcd < r ? xcd * (q + 1) : r * (q + 1) + (xcd - r) * q) + off; }
        const int nig = WGM * nN, gid = wgid / nig, fm = gid * WGM, gsz = (nM - fm) < WGM ? (nM - fm) : WGM;
        u.pm = fm + ((wgid % nig) % gsz); u.pn = (wgid % nig) / gsz; return true;
    }
    __device__ __forceinline__ void a_ready(const Unit&) const {}
    __device__ __forceinline__ void done(const Unit&) const {}
};

__device__ __forceinline__ unsigned cvt_pk_bf16(float lo, float hi) { unsigned r; asm volatile("v_cvt_pk_bf16_f32 %0, %1, %2" : "=v"(r) : "v"(lo), "v"(hi)); return r; }
typedef float f32x2 __attribute__((ext_vector_type(2)));
__device__ __forceinline__ f32x2 gelu_pk(f32x2 v) {
    const f32x2 av = __builtin_elementwise_abs(v), d = av * 0.2316418882f + 1.0f;
    f32x2 t; t.x = __builtin_amdgcn_rcpf(d.x); t.y = __builtin_amdgcn_rcpf(d.y);
    f32x2 q = t * 0.5307027145f + (-0.7265760135f); q = q * t + 0.7107068705f; q = q * t + (-0.142248368f); q = q * t + 0.127414796f; q = q * t;
    const f32x2 s = (v * v) * (-0.72134752044f);
    f32x2 e; e.x = __builtin_amdgcn_exp2f(s.x); e.y = __builtin_amdgcn_exp2f(s.y);
    const f32x2 m = v * (q * e), r = v - m;
    f32x2 o; o.x = v.x < 0.f ? m.x : r.x; o.y = v.y < 0.f ? m.y : r.y; return o;
}

template <int ACT  > struct EpiBf16 {
    static constexpr bool PERM = true, AFTER_DRAIN = false; static_assert(ACT == 0 || ACT == 1, "EpiBf16: ACT is 0 (none) or 1 (gelu_pk)");
    bf16_t* O; int ldc; const float* bias; int split_cols; size_t split_stride; float scale0;
    __device__ __forceinline__ void operator()(const f32x4 (&acc)[2][2][4][2], const Unit& u, int wr, int wc, int fr, int fq) const {
        const int row0 = u.pm * BM + wr * 64 + fr; int colt = u.pn * BM; bf16_t* base = O;
        float sc = 1.f; if (split_cols) { const int t = colt / split_cols; base += (size_t)t * split_stride; colt -= t * split_cols; if (t == 0) sc = scale0; }
        const int col0 = colt + wc * 32 + 8 * fq, bcol0 = u.pn * BM + wc * 32 + 8 * fq;
        f32x4 bv[2][2];
#pragma unroll
        for (int bj = 0; bj < 2; ++bj)
#pragma unroll
            for (int n = 0; n < 2; ++n) bv[bj][n] = bias ? *(const f32x4*)(bias + bcol0 + bj * HALF + 4 * n) : (f32x4){0.f, 0.f, 0.f, 0.f};
#pragma unroll
        for (int ai = 0; ai < 2; ++ai)
#pragma unroll
            for (int m = 0; m < 4; ++m) { bf16_t* rowp = base + (size_t)(row0 + ai * HALF + m * 16) * ldc + col0;
#pragma unroll
                for (int bj = 0; bj < 2; ++bj) { f32x4 v0 = acc[ai][bj][m][0] + bv[bj][0], v1 = acc[ai][bj][m][1] + bv[bj][1];
                    if (ACT == 1) { f32x2 a = gelu_pk((f32x2){v0[0], v0[1]}), b = gelu_pk((f32x2){v0[2], v0[3]}), c = gelu_pk((f32x2){v1[0], v1[1]}), d = gelu_pk((f32x2){v1[2], v1[3]});
                        v0 = (f32x4){a.x, a.y, b.x, b.y}; v1 = (f32x4){c.x, c.y, d.x, d.y}; }
                    v0 = v0 * sc; v1 = v1 * sc; u32x4 w; w.x = cvt_pk_bf16(v0[0], v0[1]); w.y = cvt_pk_bf16(v0[2], v0[3]); w.z = cvt_pk_bf16(v1[0], v1[1]); w.w = cvt_pk_bf16(v1[2], v1[3]);
                    *(u32x4*)(rowp + bj * HALF) = w; } }
    }
};

template <class Epi, class Sched, bool ALIGN_EPI = false, bool SP2 = false>
__device__ __forceinline__ void gemm_phase(PG8_LAS unsigned char* lds, const Gemm g, const Sched& S, const Epi& E) {
    int tid = threadIdx.x; asm volatile("" : "+v"(tid));
    const int wid = __builtin_amdgcn_readfirstlane(tid >> 6), lane = tid & 63, wr = wid >> 2, wc = wid & 3, fr = lane & 15, fq = lane >> 4;
    const int K = g.K, nt = K / BK;
    unsigned voffA[2], voffB[2];
#pragma unroll
    for (int i = 0; i < 2; ++i) { int R, C; stage_rc(tid * 16 + i * 8192, R, C); const int Rb = Epi::PERM ? ((R & ~31) + perm32(R & 31)) : R;
        voffA[i] = (unsigned)(R * BK + C) * 2u; voffB[i] = (unsigned)(Rb * BK + C) * 2u; }
    const size_t kstep = (size_t)(BM * BK * 2);
    const size_t hstep = (size_t)HALF * BK * 2;
    const size_t tstep = (size_t)BM * K * 2;
    const unsigned ldsw = (unsigned)wid * 1024u;
    const int aoff = lds_byte(wr * 64 + fr, fq * 8), boff = lds_byte(wc * 32 + fr, fq * 8);
#define PG8_SA(b, h) (((b) * 2 + (h)) * HTB)
#define PG8_SB(b, h) ((4 + (b) * 2 + (h)) * HTB)
#define PG8_STAGE(bufoff, gbase, voff) do { _Pragma("unroll") for (int _i = 0; _i < 2; ++_i) \
        __builtin_amdgcn_global_load_lds((const unsigned*)((const char*)(gbase) + (voff)[_i]), (PG8_LAS unsigned*)(lds + (bufoff) + ldsw + _i * 8192), 16, 0, 0); } while (0)
#define PG8_LDA(dst, b, h) do { _Pragma("unroll") for (int m = 0; m < 4; ++m) _Pragma("unroll") for (int k = 0; k < 2; ++k) dst[m][k] = *(const PG8_LAS bf16x8*)(lds + PG8_SA(b, h) + aoff + m * 2048 + k * 1024); } while (0)
#define PG8_LDB(dst, b, h) do { _Pragma("unroll") for (int n = 0; n < 2; ++n) _Pragma("unroll") for (int k = 0; k < 2; ++k) dst[n][k] = *(const PG8_LAS bf16x8*)(lds + PG8_SB(b, h) + boff + n * 2048 + k * 1024); } while (0)
#define PG8_MMA(ai, bj, At, Bt) do { __builtin_amdgcn_s_setprio(1); _Pragma("unroll") for (int m = 0; m < 4; ++m) _Pragma("unroll") for (int n = 0; n < 2; ++n) _Pragma("unroll") for (int k = 0; k < 2; ++k) \
        acc[ai][bj][m][n] = __builtin_amdgcn_mfma_f32_16x16x32_bf16(Bt[n][k], At[m][k], acc[ai][bj][m][n], 0, 0, 0); __builtin_amdgcn_s_setprio(0); } while (0)
#define PG8_WAIT_V(n) asm volatile("s_waitcnt vmcnt(" #n ")" ::: "memory")
#define PG8_WAIT_L(n) asm volatile("s_waitcnt lgkmcnt(" #n ")" ::: "memory")
#define PG8_BAR __builtin_amdgcn_s_barrier()
#define PG8_SCHED __builtin_amdgcn_sched_barrier(0)
    Unit cur, nxt; int ui = 0;
    if (!S.next(0, cur)) return;
    f32x4 acc[2][2][4][2];
#pragma unroll
    for (int a = 0; a < 2; ++a)
#pragma unroll
        for (int b = 0; b < 2; ++b)
#pragma unroll
            for (int m = 0; m < 4; ++m)
#pragma unroll
                for (int n = 0; n < 2; ++n) acc[a][b][m][n] = (f32x4){0.f, 0.f, 0.f, 0.f};
    bf16x8 At[4][2], B0[2][2], B1[2][2];
    const char* cA = (const char*)g.A + (size_t)cur.pm * tstep; const char* cB = (const char*)g.Bt + (size_t)cur.pn * tstep;
    S.a_ready(cur);
    if constexpr (SP2) {
        PG8_STAGE(PG8_SB(0, 0), cB, voffB); PG8_STAGE(PG8_SB(0, 1), cB + hstep, voffB); PG8_STAGE(PG8_SA(0, 0), cA, voffA); PG8_STAGE(PG8_SA(0, 1), cA + hstep, voffA);
        if (wr == 1) PG8_BAR;
        PG8_WAIT_V(2); PG8_BAR;
        PG8_STAGE(PG8_SB(1, 0), cB + kstep, voffB); PG8_STAGE(PG8_SA(1, 0), cA + kstep, voffA); PG8_STAGE(PG8_SB(1, 1), cB + hstep + kstep, voffB);
        PG8_WAIT_V(6); PG8_BAR;
    } else {
        PG8_STAGE(PG8_SB(0, 0), cB, voffB); PG8_STAGE(PG8_SA(0, 0), cA, voffA); PG8_STAGE(PG8_SB(0, 1), cB + hstep, voffB); PG8_STAGE(PG8_SA(0, 1), cA + hstep, voffA);
        if (wr == 1) PG8_BAR;
        PG8_WAIT_V(4); PG8_BAR;
        PG8_STAGE(PG8_SB(1, 0), cB + kstep, voffB); PG8_STAGE(PG8_SA(1, 0), cA + kstep, voffA); PG8_STAGE(PG8_SB(1, 1), cB + hstep + kstep, voffB);
        PG8_WAIT_V(6); PG8_BAR;
    }
    for (;;) {
        const bool has_next = S.next(ui + 1, nxt);
        const char* nA = has_next ? (const char*)g.A + (size_t)nxt.pm * tstep : cA; const char* nB = has_next ? (const char*)g.Bt + (size_t)nxt.pn * tstep : cB;
        for (int t = 0; t < nt; t += 2) {
            const bool last = (t == nt - 2);
            const char* a1 = cA + (size_t)(t + 1) * kstep;
            const char* a2 = last ? nA : cA + (size_t)(t + 2) * kstep; const char* b2 = last ? nB : cB + (size_t)(t + 2) * kstep;
            const char* a3 = a2 + kstep; const char* b3 = b2 + kstep;
            if (last && has_next) S.a_ready(nxt);
            if constexpr (SP2) {
            PG8_LDB(B0, 0, 0); PG8_LDB(B1, 0, 1); PG8_SCHED; PG8_LDA(At, 0, 0); PG8_STAGE(PG8_SA(1, 1), a1 + hstep, voffA);
            PG8_WAIT_V(8); PG8_WAIT_L(0); PG8_BAR; PG8_MMA(0, 0, At, B0); PG8_MMA(0, 1, At, B1); PG8_BAR; PG8_SCHED;
            PG8_LDA(At, 0, 1); PG8_STAGE(PG8_SB(0, 0), b2, voffB); PG8_STAGE(PG8_SB(0, 1), b2 + hstep, voffB); PG8_STAGE(PG8_SA(0, 0), a2, voffA);
            PG8_WAIT_V(8); PG8_WAIT_L(0); PG8_BAR; PG8_MMA(1, 0, At, B0); PG8_MMA(1, 1, At, B1); PG8_BAR; PG8_SCHED;
            PG8_LDB(B0, 1, 0); PG8_LDB(B1, 1, 1); PG8_SCHED; PG8_LDA(At, 1, 0); PG8_STAGE(PG8_SA(0, 1), a2 + hstep, voffA);
            PG8_WAIT_V(8); PG8_WAIT_L(0); PG8_BAR; PG8_MMA(0, 0, At, B0); PG8_MMA(0, 1, At, B1); PG8_BAR; PG8_SCHED;
            PG8_LDA(At, 1, 1); PG8_STAGE(PG8_SB(1, 0), b3, voffB); PG8_STAGE(PG8_SB(1, 1), b3 + hstep, voffB); PG8_STAGE(PG8_SA(1, 0), a3, voffA);
            PG8_WAIT_V(8); PG8_WAIT_L(0); PG8_BAR; PG8_MMA(1, 0, At, B0); PG8_MMA(1, 1, At, B1); PG8_BAR; PG8_SCHED;
            } else {
            PG8_LDB(B0, 0, 0); PG8_SCHED; PG8_LDA(At, 0, 0); PG8_STAGE(PG8_SA(1, 1), a1 + hstep, voffA);
            PG8_WAIT_L(8); PG8_BAR; PG8_WAIT_L(0); PG8_MMA(0, 0, At, B0); PG8_BAR; PG8_SCHED;
            PG8_LDB(B1, 0, 1); PG8_STAGE(PG8_SB(0, 0), b2, voffB);
            PG8_BAR; PG8_WAIT_L(0); PG8_MMA(0, 1, At, B1); PG8_BAR;
            PG8_LDA(At, 0, 1); PG8_STAGE(PG8_SA(0, 0), a2, voffA);
            PG8_BAR; PG8_WAIT_L(0); PG8_MMA(1, 0, At, B0); PG8_BAR; PG8_SCHED;
            PG8_STAGE(PG8_SB(0, 1), b2 + hstep, voffB);
            PG8_WAIT_V(6); PG8_BAR; PG8_MMA(1, 1, At, B1); PG8_BAR;
            PG8_LDB(B0, 1, 0); PG8_SCHED; PG8_LDA(At, 1, 0); PG8_STAGE(PG8_SA(0, 1), a2 + hstep, voffA);
            PG8_WAIT_L(8); PG8_BAR; PG8_WAIT_L(0); PG8_MMA(0, 0, At, B0); PG8_BAR; PG8_SCHED;
            PG8_LDB(B1, 1, 1); PG8_STAGE(PG8_SB(1, 0), b3, voffB);
            PG8_BAR; PG8_WAIT_L(0); PG8_MMA(0, 1, At, B1); PG8_BAR;
            PG8_LDA(At, 1, 1); PG8_STAGE(PG8_SA(1, 0), a3, voffA);
            PG8_BAR; PG8_WAIT_L(0); PG8_MMA(1, 0, At, B0); PG8_BAR; PG8_SCHED;
            PG8_STAGE(PG8_SB(1, 1), b3 + hstep, voffB);
            PG8_WAIT_V(6); PG8_BAR; PG8_MMA(1, 1, At, B1); PG8_BAR;
            }
        }
        if constexpr (ALIGN_EPI) { if (wr == 0) PG8_BAR; }
        const bool keep = Epi::keep_acc(cur);
        if constexpr (!Epi::AFTER_DRAIN) { if (!keep) E(acc, cur, wr, wc, fr, fq); S.done(cur); }
        if (!has_next) break;
        if (!keep)
#pragma unroll
        for (int a = 0; a < 2; ++a)
#pragma unroll
            for (int b = 0; b < 2; ++b)
#pragma unroll
                for (int m = 0; m < 4; ++m)
#pragma unroll
                    for (int n = 0; n < 2; ++n) acc[a][b][m][n] = (f32x4){0.f, 0.f, 0.f, 0.f};
        cur = nxt; cA = nA; cB = nB; ++ui;
        if constexpr (ALIGN_EPI) { if (wr == 1) PG8_BAR; }
    }
    PG8_WAIT_V(0);
    if constexpr (!ALIGN_EPI) { if (wr == 0) PG8_BAR; }
    PG8_BAR;
    if constexpr (Epi::AFTER_DRAIN) { E.fused(acc, cur, wr, wc, fr, fq, lds, wid, lane); S.done(cur); }
#undef PG8_SA
#undef PG8_SB
#undef PG8_STAGE
#undef PG8_LDA
#undef PG8_LDB
#undef PG8_MMA
#undef PG8_WAIT_V
#undef PG8_WAIT_L
#undef PG8_BAR
#undef PG8_SCHED
}
}

#ifndef PG8_SP2
#define PG8_SP2 true
#endif
#ifndef PG8_ALIGN
#define PG8_ALIGN true
#endif
#include <hip/hip_bf16.h>
#include <cmath>
namespace attn_body {
using bf16=__hip_bfloat16;
using bf16x8=__attribute__((ext_vector_type(8)))short;
using s16x4=__attribute__((ext_vector_type(4)))short;
using f32x16=__attribute__((ext_vector_type(16)))float;
using u32x4=__attribute__((ext_vector_type(4)))unsigned;
constexpr int SEQ=4096,D=64,PZ=64,PO=1024;
constexpr int NW=8,QBLK=32,QB=QBLK*NW,KVBLK=64,NQB=SEQ/QB;
constexpr int ATTN_UNIT_ROWS=QB;
__device__ __forceinline__ int crow(int r,int hi){return (r&3)+8*(r>>2)+4*hi;}
#define SBAR() __builtin_amdgcn_sched_barrier(0)
__device__ __forceinline__ void cmask(f32x16&p0,f32x16&p1,int jb,int qrel,int hi){
  const float NEG=-INFINITY; int kb=64*jb+4*hi;
  #pragma unroll
  for(int r=0;r<16;++r){int kv=kb+(r&3)+8*(r>>2); if(kv>qrel)p0[r]=NEG; if(kv+32>qrel)p1[r]=NEG;}
}

constexpr int NSLOT=3, SLOTB=8192;
constexpr int LDS_K=0, LDS_V=NSLOT*SLOTB, LDS_V2=2*NSLOT*SLOTB  , LDS_WS=3*NSLOT*SLOTB, LDS_OST=LDS_WS+NW*64*4, LDS_BYTES=LDS_OST+NW*4096;
constexpr float C2=0.125f*1.4426950408889634f;
__device__ __forceinline__ void glds16(const void*gsrc,unsigned lds_dst){unsigned keep;
  asm volatile("s_mov_b32 %0, m0\n\ts_mov_b32 m0, %2\n\ts_nop 0\n\tglobal_load_lds_dwordx4 %1, off\n\ts_mov_b32 m0, %0":"=&s"(keep):"v"(gsrc),"s"(lds_dst):"memory");}
__device__ __forceinline__ float max3f(float a,float b,float c){float r;asm("v_max3_f32 %0, %1, %2, %3":"=v"(r):"v"(a),"v"(b),"v"(c));return r;}
__device__ __forceinline__ float max2f(float a,float b){float r;asm("v_max_f32_e32 %0, %1, %2":"=v"(r):"v"(a),"v"(b));return r;}
__device__ __forceinline__ float fadd_s(float a,float b){float r;asm("v_add_f32_e32 %0, %1, %2":"=v"(r):"v"(a),"v"(b));return r;}
__device__ __forceinline__ float fsub_s(float a,float b){float r;asm("v_sub_f32_e32 %0, %1, %2":"=v"(r):"v"(a),"v"(b));return r;}
typedef float f32x2_t __attribute__((ext_vector_type(2))); typedef __bf16 bf16x2_t __attribute__((ext_vector_type(2)));
__device__ __forceinline__ unsigned cvtpk_s(float lo,float hi){f32x2_t v={lo,hi};bf16x2_t b=__builtin_convertvector(v,bf16x2_t);return __builtin_bit_cast(unsigned,b);}
#define WAIT_BAR(N) asm volatile("s_waitcnt vmcnt(" #N ") lgkmcnt(0)\n\ts_barrier":::"memory")

__device__ __forceinline__ void qkt(f32x16&p0,f32x16&p1,const char*Kslot,const bf16x8*qr,const f32x16&negm,int r32,int hi){
  const char*kb=Kslot+hi*1024+r32*16;
  #pragma unroll
  for(int d0=0;d0<4;++d0){
    const bf16x8 b0=*reinterpret_cast<const bf16x8*>(kb+d0*2048);
    const bf16x8 b1=*reinterpret_cast<const bf16x8*>(kb+d0*2048+512);
    if(d0==0){p0=__builtin_amdgcn_mfma_f32_32x32x16_bf16(b0,qr[0],negm,0,0,0);p1=__builtin_amdgcn_mfma_f32_32x32x16_bf16(b1,qr[0],negm,0,0,0);}
    else{p0=__builtin_amdgcn_mfma_f32_32x32x16_bf16(b0,qr[d0],p0,0,0,0);p1=__builtin_amdgcn_mfma_f32_32x32x16_bf16(b1,qr[d0],p1,0,0,0);}}
}
typedef __attribute__((address_space(3))) const char* lds_cptr;
typedef short v4i16_t __attribute__((ext_vector_type(4)));
__device__ __forceinline__ void kload8(bf16x8*kf,lds_cptr kp){
  kf[0]=*(const __attribute__((address_space(3))) bf16x8*)(kp);      kf[1]=*(const __attribute__((address_space(3))) bf16x8*)(kp+512);
  kf[2]=*(const __attribute__((address_space(3))) bf16x8*)(kp+2048); kf[3]=*(const __attribute__((address_space(3))) bf16x8*)(kp+2560);
  kf[4]=*(const __attribute__((address_space(3))) bf16x8*)(kp+4096); kf[5]=*(const __attribute__((address_space(3))) bf16x8*)(kp+4608);
  kf[6]=*(const __attribute__((address_space(3))) bf16x8*)(kp+6144); kf[7]=*(const __attribute__((address_space(3))) bf16x8*)(kp+6656);
}
__device__ __forceinline__ void kload2(bf16x8*kf,lds_cptr kp,int j){ kf[2*j]=*(const __attribute__((address_space(3))) bf16x8*)(kp+j*2048); kf[2*j+1]=*(const __attribute__((address_space(3))) bf16x8*)(kp+j*2048+512); }
__device__ __forceinline__ s16x4 vtr(lds_cptr p){ return __builtin_bit_cast(s16x4,__builtin_amdgcn_ds_read_tr16_b64_v4i16((__attribute__((address_space(3))) v4i16_t*)p)); }
__device__ __forceinline__ float rowmax(const f32x16&p0,const f32x16&p1){
  float a=max3f(p0[0],p0[1],p1[0]),b=max3f(p0[2],p0[3],p1[1]);a=max3f(a,p1[2],p1[3]);
  #pragma unroll
  for(int r=4;r<16;r+=4){a=max3f(a,p0[r],p0[r+1]);b=max3f(b,p0[r+2],p0[r+3]);a=max3f(a,p1[r],p1[r+1]);b=max3f(b,p1[r+2],p1[r+3]);}
  const float m=max2f(a,b);
  auto rr=__builtin_amdgcn_permlane32_swap(__float_as_uint(m),__float_as_uint(m),false,false);
  return max2f(__uint_as_float(rr[0]),__uint_as_float(rr[1]));
}
__device__ __forceinline__ void pv(f32x16*o,int vb,bf16x8 pa0,bf16x8 pa1,bf16x8 pa2,bf16x8 pa3){
  #pragma unroll
  for(int d0=0;d0<2;++d0){s16x4 lo[4],hi[4];
    #pragma unroll
    for(int ks=0;ks<4;++ks){
      asm volatile("ds_read_b64_tr_b16 %0,%1 offset:%c2":"=&v"(lo[ks]):"v"(vb),"i"(d0*4096+ks*1024):"memory");
      asm volatile("ds_read_b64_tr_b16 %0,%1 offset:%c2":"=&v"(hi[ks]):"v"(vb),"i"(d0*4096+ks*1024+512):"memory");}
    asm volatile("s_waitcnt lgkmcnt(0)":::"memory");SBAR();
    #define PK(k) (bf16x8){lo[k][0],lo[k][1],lo[k][2],lo[k][3],hi[k][0],hi[k][1],hi[k][2],hi[k][3]}
    o[d0]=__builtin_amdgcn_mfma_f32_32x32x16_bf16(pa0,PK(0),o[d0],0,0,0);
    o[d0]=__builtin_amdgcn_mfma_f32_32x32x16_bf16(pa1,PK(1),o[d0],0,0,0);
    o[d0]=__builtin_amdgcn_mfma_f32_32x32x16_bf16(pa2,PK(2),o[d0],0,0,0);
    o[d0]=__builtin_amdgcn_mfma_f32_32x32x16_bf16(pa3,PK(3),o[d0],0,0,0);
    #undef PK
  }
}

#ifndef ATTN_STORE16
#define ATTN_STORE16(p,v) (*(u32x4*)(p)=(v))
#endif
template<int THRL> __device__ __forceinline__ void attn_unit(int qb,const bf16*Q,const bf16*__restrict__ K,const bf16*__restrict__ V,bf16*O,char*shm){
  int tid=threadIdx.x; asm volatile("":"+v"(tid)); const int lane=tid&63,r32=lane&31,hi=lane>>5; const int wid=__builtin_amdgcn_readfirstlane(tid>>6);
  const int q0=qb*QB;
  const bf16*Qw=Q+(long)(q0+wid*QBLK)*PZ;
  const bf16*Kh=K,*Vh=V;
  const unsigned lds0=(unsigned)(uintptr_t)shm;
  float*wsf=(float*)(shm+LDS_WS)+wid*64;
  const bf16*ksrc=Kh+(long)lane*PZ+wid*8;
  const bf16*vsrc=Vh+(long)(16*(wid&3)+(lane>>2))*PZ+(wid>>2)*32+(lane&3)*8;
  const unsigned kdst=lds0+LDS_K+wid*1024, vdst=lds0+LDS_V+wid*1024;
  #define DMA_K(t,slot) glds16(ksrc+(long)(t)*KVBLK*PZ,(unsigned)__builtin_amdgcn_readfirstlane(kdst+(slot)))
  #define DMA_V(t,slot) do{ glds16(vsrc+(long)(t)*KVBLK*PZ,(unsigned)__builtin_amdgcn_readfirstlane(vdst+(slot))); glds16(vsrc+(long)SEQ*PZ+(long)(t)*KVBLK*PZ,(unsigned)__builtin_amdgcn_readfirstlane(vdst+NSLOT*SLOTB+(slot))); }while(0)
  const int vb0=(int)(lds0+LDS_V)+((lane>>4)&1)*32+(lane&3)*8+(4*hi+((lane&15)>>2))*64;
  const char*Kbase=shm+LDS_K; bf16x8 kf[8];
  const lds_cptr shm3=(lds_cptr)shm; const lds_cptr kp0=shm3+LDS_K+hi*1024+r32*16; const lds_cptr vp0=shm3+LDS_V+((lane>>4)&1)*32+(lane&3)*8+(4*hi+((lane&15)>>2))*64;
  const int NT=(q0+QB)/KVBLK;
  DMA_K(0,0);DMA_V(0,0);DMA_K(1,SLOTB);
  bf16x8 qr[4];
  #pragma unroll
  for(int d0=0;d0<4;++d0)qr[d0]=*reinterpret_cast<const bf16x8*>(&Qw[(long)r32*PZ+d0*16+hi*8]);
  float mhat=0.f,l_reg=0.f;f32x16 o[4];o[0]=f32x16{};o[1]=f32x16{};o[2]=f32x16{};o[3]=f32x16{};f32x16 negm=f32x16{};asm volatile("":"+v"(negm));
  const int qrel=wid*QBLK+r32;
  #define CMASK(P0,P1,t) do{int jb_=(t)-(NT-4); if(jb_>=0)cmask(P0,P1,jb_,qrel,hi);}while(0)
  bool resc=false;
  #define START(P0,P1) do{ const float rm=rowmax(P0,P1); resc=false; \
    { const float dl=rm; mhat=fadd_s(mhat,dl); \
      _Pragma("unroll") for(int r=0;r<16;++r){P0[r]=fsub_s(P0[r],dl);P1[r]=fsub_s(P1[r],dl);} \
      _Pragma("unroll") for(int r=0;r<16;++r)negm[r]=-mhat; asm volatile("":"+v"(negm)); } \
    _Pragma("unroll") for(int r=0;r<16;++r)P0[r]=__builtin_amdgcn_exp2f(P0[r]); }while(0)
  #define RESC() do{ if(resc){ asm volatile("s_waitcnt lgkmcnt(0)":::"memory"); \
      _Pragma("unroll") for(int d_=0;d_<4;++d_) _Pragma("unroll") for(int r=0;r<16;++r)o[d_][r]*=wsf[crow(r,hi)]; } }while(0)
  f32x16 pA0,pA1,pB0,pB1;
  int sl_prev=0,sl_cur=0,sl_next=SLOTB;
  #define ROT() do{sl_prev=sl_cur;sl_cur=sl_next;sl_next=(sl_next==(NSLOT-1)*SLOTB)?0:sl_next+SLOTB;}while(0)
  DMA_K(2,2*SLOTB);
  WAIT_BAR(4);
  qkt(pA0,pA1,Kbase,qr,negm,r32,hi);asm volatile("s_nop 15\n\ts_nop 7":"+v"(pA0),"+v"(pA1));CMASK(pA0,pA1,0);
  START(pA0,pA1);
  _Pragma("unroll") for(int r=0;r<16;++r)pA1[r]=__builtin_amdgcn_exp2f(pA1[r]);
  WAIT_BAR(0);
  DMA_K(3,0);DMA_V(1,SLOTB);
  ROT();
  kload8(kf,kp0+sl_cur);
  WAIT_BAR(3);
  s16x4 vlo[8],vhi[8]; u32x4 pw0,pw1,pw2,pw3;
  #define PKW(P,B) cvtpk_s(P[B],P[B+1])
  #define PAF(k) __builtin_bit_cast(bf16x8,pw##k)
  #define VFR(i) (bf16x8){vlo[i][0],vlo[i][1],vlo[i][2],vlo[i][3],vhi[i][0],vhi[i][1],vhi[i][2],vhi[i][3]}
  #define PIN(x) asm volatile("":"+v"(x))
  #define MX3(a,b,c) __builtin_fmaxf(__builtin_fmaxf((a),(b)),(c))
  #define GAPA(MF,A0,A1,A2,A3,W0,W1,PW) do{ MF; sacc+=A0; sacc+=A1; sacc+=A2; sacc+=A3; PIN(sacc); W0; W1; PIN(PW); SBAR(); }while(0)
  #define EX(v) __builtin_amdgcn_exp2f(v)
  #define GAPB(MF,X,B) do{ MF; X[B]=EX(X[B]); X[B+1]=EX(X[B+1]); X[B+2]=EX(X[B+2]); X[B+3]=EX(X[B+3]); PIN(X); SBAR(); }while(0)
  #define GAPE(MF,X,B) do{ MF; X[B]=EX(X[B]); X[B+1]=EX(X[B+1]); PIN(X); SBAR(); }while(0)
  #define VRD(i) do{ vlo[i]=vtr(vp_+(((i)>>2)*4096+((i)&3)*1024)); vhi[i]=vtr(vp_+(((i)>>2)*4096+((i)&3)*1024+512)); }while(0)
  #define VRD2(i) do{ vlo[i]=vtr(vp_+(NSLOT*SLOTB+((i)>>2)*4096+((i)&3)*1024)); vhi[i]=vtr(vp_+(NSLOT*SLOTB+((i)>>2)*4096+((i)&3)*1024+512)); SBAR(); }while(0)
  #define KRD(G,j) do{ if(G){ kload2(kf,kp0+sl_next,j); SBAR(); } }while(0)
  #define STEP(C0,C1,P0,P1,t,GK,GV,GL) do{ SBAR(); \
    const lds_cptr vp_=vp0+sl_prev; \
    VRD(0); SBAR(); float sacc=(P0[0]+P0[1]); \
    GAPA(C0=__builtin_amdgcn_mfma_f32_32x32x16_bf16(kf[0],qr[0],negm,0,0,0), P0[2],P0[3],P0[4],P0[5],     pw0[0]=PKW(P0,0), pw0[1]=PKW(P0,2), pw0); \
    VRD(4); SBAR(); GAPA(C1=__builtin_amdgcn_mfma_f32_32x32x16_bf16(kf[1],qr[0],negm,0,0,0), P0[6],P0[7],P0[8],P0[9],     pw0[2]=PKW(P0,4), pw0[3]=PKW(P0,6), pw0); \
    VRD(1); SBAR(); GAPA(C0=__builtin_amdgcn_mfma_f32_32x32x16_bf16(kf[2],qr[1],C0,0,0,0),   P0[10],P0[11],P0[12],P0[13], pw1[0]=PKW(P0,8), pw1[1]=PKW(P0,10), pw1); \
    VRD(5); SBAR(); GAPA(C1=__builtin_amdgcn_mfma_f32_32x32x16_bf16(kf[3],qr[1],C1,0,0,0),   P0[14],P0[15],P1[0],P1[1],   pw1[2]=PKW(P0,12),pw1[3]=PKW(P0,14), pw1); \
    VRD(2); SBAR(); GAPA(C0=__builtin_amdgcn_mfma_f32_32x32x16_bf16(kf[4],qr[2],C0,0,0,0),   P1[2],P1[3],P1[4],P1[5],     pw2[0]=PKW(P1,0), pw2[1]=PKW(P1,2), pw2); \
    VRD(6); SBAR(); GAPA(C1=__builtin_amdgcn_mfma_f32_32x32x16_bf16(kf[5],qr[2],C1,0,0,0),   P1[6],P1[7],P1[8],P1[9],     pw2[2]=PKW(P1,4), pw2[3]=PKW(P1,6), pw2); \
    VRD(3); SBAR(); GAPA(C0=__builtin_amdgcn_mfma_f32_32x32x16_bf16(kf[6],qr[3],C0,0,0,0),   P1[10],P1[11],P1[12],P1[13], pw3[0]=PKW(P1,8), pw3[1]=PKW(P1,10), pw3); \
    VRD(7); SBAR(); GAPA(C1=__builtin_amdgcn_mfma_f32_32x32x16_bf16(kf[7],qr[3],C1,0,0,0),   P1[14],P1[15],0.f,0.f,       pw3[2]=PKW(P1,12),pw3[3]=PKW(P1,14), pw3); \
    l_reg+=sacc; \
    if(GK){DMA_K((t)+3,sl_cur);} if(GV){DMA_V((t)+1,sl_next);} \
    CMASK(C0,C1,t); \
    { float a=MX3(C0[0],C0[1],C1[0]),b=MX3(C0[2],C0[3],C1[1]); a=MX3(a,C1[2],C1[3]); \
      _Pragma("unroll") for(int r=4;r<16;r+=4){a=MX3(a,C0[r],C0[r+1]);b=MX3(b,C0[r+2],C0[r+3]);a=MX3(a,C1[r],C1[r+1]);b=MX3(b,C1[r+2],C1[r+3]);} \
      float rm=__builtin_fmaxf(a,b); { auto rr=__builtin_amdgcn_permlane32_swap(__float_as_uint(rm),__float_as_uint(rm),false,false); rm=__builtin_fmaxf(__uint_as_float(rr[0]),__uint_as_float(rr[1])); } \
      resc=false; \
      if(__builtin_expect(__any(rm>(float)THRL),0)){ const float dl=__builtin_fmaxf(rm,0.f); mhat+=dl; \
        _Pragma("unroll") for(int r=0;r<16;++r){C0[r]-=dl;C1[r]-=dl;} \
        _Pragma("unroll") for(int r=0;r<16;++r)negm[r]=-mhat; asm volatile("":"+v"(negm)); \
        const float f=__builtin_amdgcn_exp2f(-dl); l_reg*=f; if(hi==0)wsf[r32]=f; resc=true; } } \
    SBAR(); \
    GAPE(o[0]=__builtin_amdgcn_mfma_f32_32x32x16_bf16(PAF(0),VFR(0),o[0],0,0,0), C0,0); VRD2(0); \
    GAPE(o[1]=__builtin_amdgcn_mfma_f32_32x32x16_bf16(PAF(0),VFR(4),o[1],0,0,0), C0,2); VRD2(4); \
    KRD(GL,0); GAPE(o[0]=__builtin_amdgcn_mfma_f32_32x32x16_bf16(PAF(1),VFR(1),o[0],0,0,0), C0,4); VRD2(1); \
    KRD(GL,1); GAPE(o[1]=__builtin_amdgcn_mfma_f32_32x32x16_bf16(PAF(1),VFR(5),o[1],0,0,0), C0,6); VRD2(5); \
    KRD(GL,2); GAPE(o[0]=__builtin_amdgcn_mfma_f32_32x32x16_bf16(PAF(2),VFR(2),o[0],0,0,0), C0,8); VRD2(2); \
    KRD(GL,3); GAPE(o[1]=__builtin_amdgcn_mfma_f32_32x32x16_bf16(PAF(2),VFR(6),o[1],0,0,0), C0,10); VRD2(6); \
    GAPE(o[0]=__builtin_amdgcn_mfma_f32_32x32x16_bf16(PAF(3),VFR(3),o[0],0,0,0), C0,12); VRD2(3); \
    GAPE(o[1]=__builtin_amdgcn_mfma_f32_32x32x16_bf16(PAF(3),VFR(7),o[1],0,0,0), C0,14); VRD2(7); \
      \
    GAPE(o[2]=__builtin_amdgcn_mfma_f32_32x32x16_bf16(PAF(0),VFR(0),o[2],0,0,0), C1,0); \
    GAPE(o[3]=__builtin_amdgcn_mfma_f32_32x32x16_bf16(PAF(0),VFR(4),o[3],0,0,0), C1,2); \
    GAPE(o[2]=__builtin_amdgcn_mfma_f32_32x32x16_bf16(PAF(1),VFR(1),o[2],0,0,0), C1,4); \
    GAPE(o[3]=__builtin_amdgcn_mfma_f32_32x32x16_bf16(PAF(1),VFR(5),o[3],0,0,0), C1,6); \
    GAPE(o[2]=__builtin_amdgcn_mfma_f32_32x32x16_bf16(PAF(2),VFR(2),o[2],0,0,0), C1,8); \
    GAPE(o[3]=__builtin_amdgcn_mfma_f32_32x32x16_bf16(PAF(2),VFR(6),o[3],0,0,0), C1,10); \
    GAPE(o[2]=__builtin_amdgcn_mfma_f32_32x32x16_bf16(PAF(3),VFR(3),o[2],0,0,0), C1,12); \
    GAPE(o[3]=__builtin_amdgcn_mfma_f32_32x32x16_bf16(PAF(3),VFR(7),o[3],0,0,0), C1,14); \
    }while(0)
  int t=1;
  #undef CMASK
  #define CMASK(P0,P1,t) do{}while(0)
  for(;t+5<NT;t+=2){
    STEP(pB0,pB1,pA0,pA1,t,true,true,true);     WAIT_BAR(3); RESC(); ROT();
    STEP(pA0,pA1,pB0,pB1,t+1,true,true,true);   WAIT_BAR(3); RESC(); ROT();
  }
  #undef CMASK
  #define CMASK(P0,P1,t) do{int jb_=(t)-(NT-4); if(jb_>=0)cmask(P0,P1,jb_,qrel,hi);}while(0)
  #define ENDW(tt) do{ if((tt)+3<NT){WAIT_BAR(3);} else if((tt)+2<NT){WAIT_BAR(2);} else {WAIT_BAR(0);} }while(0)
  for(;t+1<NT;t+=2){
    STEP(pB0,pB1,pA0,pA1,t,(t+3<NT),(t+1<NT),(t+1<NT));       ENDW(t);   RESC(); ROT();
    STEP(pA0,pA1,pB0,pB1,t+1,(t+4<NT),(t+2<NT),(t+2<NT));     ENDW(t+1); RESC(); ROT();
  }
  STEP(pB0,pB1,pA0,pA1,NT-1,false,false,false); RESC();
  { float sacc=pB0[0]+pB0[1]; _Pragma("unroll") for(int r=2;r<16;++r)sacc+=pB0[r]; _Pragma("unroll") for(int r=0;r<16;++r)sacc+=pB1[r]; l_reg+=sacc;
    pw0=(u32x4){PKW(pB0,0),PKW(pB0,2),PKW(pB0,4),PKW(pB0,6)};pw1=(u32x4){PKW(pB0,8),PKW(pB0,10),PKW(pB0,12),PKW(pB0,14)};pw2=(u32x4){PKW(pB1,0),PKW(pB1,2),PKW(pB1,4),PKW(pB1,6)};pw3=(u32x4){PKW(pB1,8),PKW(pB1,10),PKW(pB1,12),PKW(pB1,14)};
    SBAR(); pv(o,vb0+sl_cur,PAF(0),PAF(1),PAF(2),PAF(3)); pv(o+2,vb0+NSLOT*SLOTB+sl_cur,PAF(0),PAF(1),PAF(2),PAF(3)); }
  #undef PKW
  #undef PAF
  #undef VFR
  #undef PIN
  #undef MX3
  #undef GAPA
  #undef GAPB
  #undef GAPE
  #undef EX
  #undef VRD
  #undef VRD2
  #undef KRD
  #undef STEP
  #undef ENDW
  {auto rr=__builtin_amdgcn_permlane32_swap(__float_as_uint(l_reg),__float_as_uint(l_reg),false,false);l_reg=__uint_as_float(rr[0])+__uint_as_float(rr[1]);}
  if(hi==0)wsf[32+r32]=l_reg;asm volatile("s_waitcnt lgkmcnt(0)":::"memory");
  float rli[16];
  #pragma unroll
  for(int r=0;r<16;++r)rli[r]=__builtin_amdgcn_rcpf(wsf[32+crow(r,hi)]);
  bf16*Ow=O+(long)(q0+wid*QBLK)*PO;
  { bf16*stg=(bf16*)(shm+LDS_OST)+wid*2048;
    #pragma unroll
    for(int hf=0;hf<2;++hf){
      #pragma unroll
      for(int r=0;r<16;++r){const int orow=crow(r,hi);
        #pragma unroll
        for(int d0=0;d0<2;++d0)stg[orow*64+d0*32+r32]=__float2bfloat16(o[2*hf+d0][r]*rli[r]);}
      asm volatile("s_waitcnt lgkmcnt(0)":::"memory");
      #pragma unroll
      for(int i=0;i<4;++i){const int row=i*8+(lane>>3),ch=lane&7; const u32x4 v=*(const u32x4*)(stg+row*64+ch*8); ATTN_STORE16(Ow+(long)row*PO+hf*64+ch*8,v);}
      asm volatile("s_waitcnt lgkmcnt(0)":::"memory"); } }
  asm volatile("s_waitcnt lgkmcnt(0)\n\ts_barrier":::"memory");
  #undef DMA_K
  #undef DMA_V
  #undef CMASK
  #undef START
  #undef RESC
  #undef ROT
}
constexpr int ATTN_LDS_BYTES=LDS_BYTES;
#undef SBAR
#undef WAIT_BAR
}

#include <hip/hip_cooperative_groups.h>
namespace cg = cooperative_groups;
#define LAS __attribute__((address_space(3)))
typedef unsigned short u16;
typedef unsigned v4u __attribute__((ext_vector_type(4)));
typedef unsigned v2u __attribute__((ext_vector_type(2)));
typedef float v4f __attribute__((ext_vector_type(4)));
typedef short v8s __attribute__((ext_vector_type(8)));

constexpr int NWAVES = 8, NTHR = 512;
constexpr int BATCH = 8, SEQ = 4096, DM = 1024, MROWS = BATCH * SEQ, MH = MROWS / 2, FF = 2816, NIN = 5896, ZP = 2816, ZPB = 2 * ZP, ZGATE_B = 5 * 512, NLAYER = 2;
constexpr float EPS = 1e-6f;
constexpr float QC2 = 0.125f * 1.4426950408889634f;
constexpr int LDS_BYTES = 147456;

constexpr size_t MiB = 1u << 20, KiB = 1u << 10;
constexpr size_t WS_BAR = 0, CTL_ZERO_BYTES = 64 * KiB;
constexpr size_t WS_W = 2 * MiB, W_LSTRIDE = 49 * MiB;
constexpr size_t WO_13A = 0, WO_2A = 11 * MiB, WO_IN = 16 * MiB + 512 * KiB, WO_PA = 28 * MiB + 512 * KiB, WO_PB = 29 * MiB, WO_PC = 29 * MiB + 512 * KiB,
                 WO_OUT = 30 * MiB + 512 * KiB, WO_13B = 32 * MiB + 512 * KiB, WO_2B = 43 * MiB + 512 * KiB;
constexpr size_t WS_XB = 100 * MiB, WS_ZA = 164 * MiB, WS_O = 340 * MiB, WS_QC = 372 * MiB, WS_KC = 388 * MiB, WS_VC = 404 * MiB, WS_MG = WS_QC  , WS_U = 420 * MiB, WS_CST = 436 * MiB,
                 WS_YA = 444 * MiB, WS_YB = 452 * MiB, WS_YC = 460 * MiB, WS_MIF = 476 * MiB, WS_COS = 477 * MiB, WS_SIN = 481 * MiB, WS_SSP = 485 * MiB,
                 WS_NU = 487 * MiB, WS_NST = 487 * MiB + 256 * KiB, WS_ML = 487 * MiB + 512 * KiB, WS_BL = WS_ML + 4 * KiB, WS_MST = WS_BL + 4 * KiB, WS_END = 488 * MiB;
static_assert((size_t)MH * ZP * 2 <= WS_O - WS_ZA && (size_t)MROWS * FF * 2 <= WS_O - WS_ZA, "z / act region");

__device__ __forceinline__ unsigned f2bf(float f) { unsigned u = __builtin_bit_cast(unsigned, f); return (u + 0x7fffu + ((u >> 16) & 1u)) >> 16; }
typedef float f32x2_ __attribute__((ext_vector_type(2))); typedef __bf16 bf16x2_ __attribute__((ext_vector_type(2)));
__device__ __forceinline__ unsigned pk2(float lo, float hi) { const f32x2_ v = {lo, hi}; const bf16x2_ b = __builtin_convertvector(v, bf16x2_); return __builtin_bit_cast(unsigned, b); }
__device__ __forceinline__ float bflo(unsigned w) { return __uint_as_float(w << 16); }
__device__ __forceinline__ float bfhi(unsigned w) { return __uint_as_float(w & 0xffff0000u); }
__device__ __forceinline__ void unpack8(const v4u r, float* x) { x[0] = bflo(r.x); x[1] = bfhi(r.x); x[2] = bflo(r.y); x[3] = bfhi(r.y); x[4] = bflo(r.z); x[5] = bfhi(r.z); x[6] = bflo(r.w); x[7] = bfhi(r.w); }
__device__ __forceinline__ v4u pack8(const float* x) { v4u o; o.x = pk2(x[0], x[1]); o.y = pk2(x[2], x[3]); o.z = pk2(x[4], x[5]); o.w = pk2(x[6], x[7]); return o; }
__device__ __forceinline__ float sigmoidf_(float x) { return __builtin_amdgcn_rcpf(1.0f + __builtin_amdgcn_exp2f(-1.4426950408889634f * x)); }
__device__ __forceinline__ float siluf_(float x) { return x * __builtin_amdgcn_rcpf(1.0f + __builtin_amdgcn_exp2f(-1.4426950408889634f * x)); }
__device__ __forceinline__ float shl_(float v, int src) { return __int_as_float(__builtin_amdgcn_ds_bpermute(src << 2, __float_as_int(v))); }
__device__ __forceinline__ float shx_(float v, int lane, int o) { return shl_(v, lane ^ o); }
template <int CTRL, int ROWMASK> __device__ __forceinline__ float dpp_(float oldv, float src) {
    return __int_as_float(__builtin_amdgcn_update_dpp(__float_as_int(oldv), __float_as_int(src), CTRL, ROWMASK, 0xF, false));
}
__device__ __forceinline__ float wave_incl_sum(float v, int) {
    v += dpp_<0x111, 0xF>(0.f, v); v += dpp_<0x112, 0xF>(0.f, v); v += dpp_<0x114, 0xF>(0.f, v); v += dpp_<0x118, 0xF>(0.f, v);
    v += dpp_<0x142, 0xA>(0.f, v); v += dpp_<0x143, 0xC>(0.f, v);
    return v;
}
__device__ __forceinline__ float wave_incl_max(float v, int) {
    const float ninf = -__builtin_inff();
    v = fmaxf(v, dpp_<0x111, 0xF>(ninf, v)); v = fmaxf(v, dpp_<0x112, 0xF>(ninf, v)); v = fmaxf(v, dpp_<0x114, 0xF>(ninf, v)); v = fmaxf(v, dpp_<0x118, 0xF>(ninf, v));
    v = fmaxf(v, dpp_<0x142, 0xA>(ninf, v)); v = fmaxf(v, dpp_<0x143, 0xC>(ninf, v));
    return v;
}
__device__ __forceinline__ float lane63_(float v) { return __int_as_float(__builtin_amdgcn_readlane(__float_as_int(v), 63)); }
__device__ __forceinline__ float wave_sum(float v, int lane) { return lane63_(wave_incl_sum(v, lane)); }
__device__ __forceinline__ float wave_max(float v, int lane) { return lane63_(wave_incl_max(v, lane)); }
__device__ __forceinline__ float red8(float v) {
    v += dpp_<0xB1, 0xF>(0.f, v); v += dpp_<0x4E, 0xF>(0.f, v); v += dpp_<0x141, 0xF>(0.f, v);
    return v;
}
__device__ __forceinline__ float red16(float v) { v = red8(v); v += dpp_<0x140, 0xF>(0.f, v); return v; }
__device__ __forceinline__ float logsigmoidf_(float x) { return fminf(x, 0.f) - __logf(1.0f + __expf(-fabsf(x))); }
__device__ __forceinline__ size_t tl(int row, int col, int K) { return (size_t)(row >> 8) * ((size_t)256 * K) + (size_t)(col >> 6) * (256 * 64) + (size_t)((row & 255) * 64 + (col & 63)); }
__device__ __forceinline__ float rstd_from_quarter(const v4f a, int ln) {
    float s = (a.x + a.y) + (a.z + a.w);
    s += __int_as_float(__builtin_amdgcn_ds_bpermute((ln ^ 16) << 2, __float_as_int(s))); s += __int_as_float(__builtin_amdgcn_ds_bpermute((ln ^ 32) << 2, __float_as_int(s)));
    return rsqrtf(s * (1.0f / DM) + EPS);
}
__device__ __forceinline__ float row_rstd4(const float* ssp, int row, int fq, int ln) {
    const v4f a = *(const v4f*)(ssp + (size_t)row * 16 + 4 * fq);
    float s = (a.x + a.y) + (a.z + a.w);
    s += __int_as_float(__builtin_amdgcn_ds_bpermute((ln ^ 16) << 2, __float_as_int(s))); s += __int_as_float(__builtin_amdgcn_ds_bpermute((ln ^ 32) << 2, __float_as_int(s)));
    return rsqrtf(s * (1.0f / DM) + EPS);
}
__device__ __forceinline__ float row_rstd(const float* ssp, int row) {
    const v4f* p = (const v4f*)(ssp + (size_t)row * 16);
    const v4f a = p[0], b = p[1], c = p[2], d = p[3];
    const float s = ((a.x + a.y) + (a.z + a.w)) + ((b.x + b.y) + (b.z + b.w)) + ((c.x + c.y) + (c.z + c.w)) + ((d.x + d.y) + (d.z + d.w));
    return rsqrtf(s * (1.0f / DM) + EPS);
}

namespace pg8 {
__device__ __forceinline__ f32x4 sigmoid4(f32x4 x) {
    const f32x4 z = x * (-1.4426950408889634f); f32x4 e;
    e[0] = __builtin_amdgcn_exp2f(z[0]); e[1] = __builtin_amdgcn_exp2f(z[1]); e[2] = __builtin_amdgcn_exp2f(z[2]); e[3] = __builtin_amdgcn_exp2f(z[3]);
    const f32x4 d = e + 1.0f; f32x4 r;
    r[0] = __builtin_amdgcn_rcpf(d[0]); r[1] = __builtin_amdgcn_rcpf(d[1]); r[2] = __builtin_amdgcn_rcpf(d[2]); r[3] = __builtin_amdgcn_rcpf(d[3]);
    return r;
}
struct EpiSwiglu {
    static constexpr bool PERM = true, AFTER_DRAIN = false;
    static __device__ __forceinline__ bool keep_acc(const Unit&) { return false; }
    bf16_t* O; const float* ssp;
    __device__ __forceinline__ void operator()(const f32x4 (&acc)[2][2][4][2], const Unit& u, int wr, int wc, int, int) const {
        int t_ = threadIdx.x; asm volatile("" : "+v"(t_)); const int fr = t_ & 15, fq = (t_ >> 4) & 3;
        const int row0 = u.pm * BM + wr * 64 + fr, col0 = u.pn * HALF + wc * 32 + 8 * fq;
        v4f pq[2][4];
#pragma unroll
        for (int ai = 0; ai < 2; ++ai)
#pragma unroll
            for (int m = 0; m < 4; ++m) pq[ai][m] = *(const v4f*)(ssp + (size_t)(row0 + ai * HALF + m * 16) * 16 + 4 * fq);
        asm volatile("" ::: "memory");
#pragma unroll
        for (int ai = 0; ai < 2; ++ai)
#pragma unroll
            for (int m = 0; m < 4; ++m) {
                const int row = row0 + ai * HALF + m * 16; const float rs = rstd_from_quarter(pq[ai][m], fq * 16 + fr);
                float h[8];
#pragma unroll
                for (int n = 0; n < 2; ++n) { const f32x4 g = acc[ai][0][m][n] * rs, uu = acc[ai][1][m][n] * rs; const f32x4 hv = (g * sigmoid4(g)) * uu;
                    h[n * 4 + 0] = hv[0]; h[n * 4 + 1] = hv[1]; h[n * 4 + 2] = hv[2]; h[n * 4 + 3] = hv[3]; }
                *(u32x4*)(O + tl(row, col0, FF)) = pack8(h);
            }
    }
};
struct EpiResid {
    static constexpr bool PERM = true, AFTER_DRAIN = false;
    static __device__ __forceinline__ bool keep_acc(const Unit&) { return false; }
    const float* x0; bf16_t* xb; float* ssp; float scale;
    __device__ __forceinline__ void operator()(const f32x4 (&acc)[2][2][4][2], const Unit& u, int wr, int wc, int, int) const {
        int t_ = threadIdx.x; asm volatile("" : "+v"(t_)); const int fr = t_ & 15, fq = (t_ >> 4) & 3;
        const int row0 = u.pm * BM + wr * 64 + fr, col0 = u.pn * BM + wc * 32 + 8 * fq;
        u32x4 old[2][4][2];
#pragma unroll
        for (int ai = 0; ai < 2; ++ai)
#pragma unroll
            for (int m = 0; m < 4; ++m)
#pragma unroll
                for (int bj = 0; bj < 2; ++bj) old[ai][m][bj] = *(const u32x4*)(xb + tl(row0 + ai * HALF + m * 16, col0 + bj * HALF, DM));
        asm volatile("" ::: "memory");
#pragma unroll
        for (int ai = 0; ai < 2; ++ai)
#pragma unroll
            for (int m = 0; m < 4; ++m) {
                const int row = row0 + ai * HALF + m * 16; float ss = 0.f;
#pragma unroll
                for (int bj = 0; bj < 2; ++bj) {
                    float b[8], v[8]; unpack8(old[ai][m][bj], b);
#pragma unroll
                    for (int n = 0; n < 2; ++n)
#pragma unroll
                        for (int i = 0; i < 4; ++i) { const float t = b[n * 4 + i] + acc[ai][bj][m][n][i] * scale; v[n * 4 + i] = t; ss += t * t; }
                    *(u32x4*)(xb + tl(row, col0 + bj * HALF, DM)) = pack8(v);
                }
                { const int ln = fq * 16 + fr; ss += shx_(ss, ln, 16); ss += shx_(ss, ln, 32); }
                if (fq == 0) ssp[(size_t)row * 16 + u.pn * 4 + wc] = ss;
            }
    }
};
struct EpiWin {
    static constexpr bool PERM = true, AFTER_DRAIN = false;
    static __device__ __forceinline__ bool keep_acc(const Unit&) { return false; }
    bf16_t* Z; bf16_t* QC; bf16_t* KC; bf16_t* VC; float* mif; const float* ssp; const float* cosT; const float* sinT; const float* gate_b;
    __device__ __forceinline__ void operator()(const f32x4 (&acc)[2][2][4][2], const Unit& u, int wr, int wc, int, int) const {
        int t_ = threadIdx.x; asm volatile("" : "+v"(t_)); const int fr = t_ & 15, fq = (t_ >> 4) & 3;
        const int row0 = u.pm * BM + wr * 64 + fr, tile = u.pn;
        const bool rot = tile >= 5 && tile <= 8;
#pragma unroll
        for (int ab = 0; ab < 4; ++ab) {
            const int ai = ab >> 1;
            v4f pq[2]; v4f cs[2][4];
#pragma unroll
            for (int mm = 0; mm < 2; ++mm) { const int row = row0 + ai * HALF + ((ab & 1) * 2 + mm) * 16;
                pq[mm] = *(const v4f*)(ssp + (size_t)row * 16 + 4 * fq);
                if (rot) { const v4f* cp = (const v4f*)(cosT + (size_t)row * 32 + 8 * fq); const v4f* sp = (const v4f*)(sinT + (size_t)row * 32 + 8 * fq);
                    cs[mm][0] = cp[0]; cs[mm][1] = cp[1]; cs[mm][2] = sp[0]; cs[mm][3] = sp[1]; } }
            asm volatile("" ::: "memory");
#pragma unroll
            for (int mm = 0; mm < 2; ++mm) { const int m = (ab & 1) * 2 + mm;
                const int row = row0 + ai * HALF + m * 16; const float rs = rstd_from_quarter(pq[mm], fq * 16 + fr);
                float v0[8], v1[8];
#pragma unroll
                for (int n = 0; n < 2; ++n)
#pragma unroll
                    for (int i = 0; i < 4; ++i) { v0[n * 4 + i] = acc[ai][0][m][n][i] * rs; v1[n * 4 + i] = acc[ai][1][m][n][i] * rs; }
                bf16_t* zr = Z + (size_t)row * ZP + (tile < 5 ? tile : 0) * 256;
                const int bl_ = row >> 12, sq_ = row & (SEQ - 1);
                if (tile >= 5 && tile <= 8) {
                    const v4f c0 = cs[mm][0], c1 = cs[mm][1], s0 = cs[mm][2], s1 = cs[mm][3];
                    const float cc[8] = {c0.x, c0.y, c0.z, c0.w, c1.x, c1.y, c1.z, c1.w}, sn[8] = {s0.x, s0.y, s0.z, s0.w, s1.x, s1.y, s1.z, s1.w};
                    const float qs = tile < 7 ? QC2 : 1.0f;
                    float o0[8], o1[8];
#pragma unroll
                    for (int i = 0; i < 8; ++i) { o0[i] = (v0[i] * cc[i] - v1[i] * sn[i]) * qs; o1[i] = (v1[i] * cc[i] + v0[i] * sn[i]) * qs; }
                    bf16_t* dst = (tile < 7 ? QC : KC) + ((size_t)((bl_ * 8 + ((tile - 5) & 1) * 4 + wc) * SEQ + sq_)) * 64 + 8 * fq;
                    *(u32x4*)(dst) = pack8(o0);
                    *(u32x4*)(dst + 32) = pack8(o1);
                } else if (tile == 23) {
                    if (wc == 0 && fq == 0) {
                        float* mo = mif + (size_t)row * 8;
                        *(v4f*)(mo) = (v4f){v0[0] + gate_b[0], v0[1] + gate_b[1], v0[2] + gate_b[2], v0[3] + gate_b[3]};
                        *(v4f*)(mo + 4) = (v4f){v0[4] + gate_b[4], v0[5] + gate_b[5], v0[6] + gate_b[6], v0[7] + gate_b[7]};
                    }
                } else if (tile == 9 || tile == 10) {
                    bf16_t* d0 = VC + ((size_t)(((bl_ * 4 + (tile - 9) * 2 + 0) * 2 + (wc >> 1)) * SEQ + sq_)) * 64 + (wc & 1) * 32 + 8 * fq;
                    bf16_t* d1 = VC + ((size_t)(((bl_ * 4 + (tile - 9) * 2 + 1) * 2 + (wc >> 1)) * SEQ + sq_)) * 64 + (wc & 1) * 32 + 8 * fq;
                    *(u32x4*)d0 = pack8(v0); *(u32x4*)d1 = pack8(v1);
                } else {
                    if (tile >= 11) {
                        v2u q0, q1;
#pragma unroll
                        for (int n = 0; n < 2; ++n) { const f32x4 s0 = sigmoid4((f32x4){v0[n * 4], v0[n * 4 + 1], v0[n * 4 + 2], v0[n * 4 + 3]}) * 255.0f, s1 = sigmoid4((f32x4){v1[n * 4], v1[n * 4 + 1], v1[n * 4 + 2], v1[n * 4 + 3]}) * 255.0f;
                            const unsigned a = (unsigned)__builtin_rintf(s0[0]) | ((unsigned)__builtin_rintf(s0[1]) << 8) | ((unsigned)__builtin_rintf(s0[2]) << 16) | ((unsigned)__builtin_rintf(s0[3]) << 24);
                            const unsigned b = (unsigned)__builtin_rintf(s1[0]) | ((unsigned)__builtin_rintf(s1[1]) << 8) | ((unsigned)__builtin_rintf(s1[2]) << 16) | ((unsigned)__builtin_rintf(s1[3]) << 24);
                            if (n == 0) { q0.x = a; q1.x = b; } else { q0.y = a; q1.y = b; } }
                        unsigned char* gp = (unsigned char*)Z + (size_t)row * ZPB + ZGATE_B + (tile - 11) * 256 + wc * 32 + 8 * fq;
                        *(v2u*)gp = q0; *(v2u*)(gp + HALF) = q1;
                    } else {
                    *(u32x4*)(zr + wc * 32 + 8 * fq) = pack8(v0);
                    *(u32x4*)(zr + HALF + wc * 32 + 8 * fq) = pack8(v1);
                    }
                }
            }
            asm volatile("" ::: "memory");
        }
    }
};
struct EpiMerge {
    static constexpr bool PERM = true, AFTER_DRAIN = false;
    static __device__ __forceinline__ bool keep_acc(const Unit& u) { return (u.pm >> 6) == 2; }
    const bf16_t* Z; bf16_t* Mg;
    __device__ __forceinline__ void operator()(const f32x4 (&acc)[2][2][4][2], const Unit& u, int wr, int wc, int, int) const {
        int t_ = threadIdx.x; asm volatile("" : "+v"(t_)); const int fr = t_ & 15, fq = (t_ >> 4) & 3;
        const int br = u.pm >> 6, pm = u.pm & 63, pn = u.pn & 3, gb = br < 2 ? br : 2;
        const unsigned char* Zg = (const unsigned char*)Z + ZGATE_B + gb * 1024;
        const int row0 = pm * BM + wr * 64 + fr, col0 = pn * BM + wc * 32 + 8 * fq;
#pragma unroll
        for (int ai = 0; ai < 2; ++ai) {
            v2u gq[4][2]; u32x4 mo[4][2];
#pragma unroll
            for (int m = 0; m < 4; ++m)
#pragma unroll
                for (int bj = 0; bj < 2; ++bj) { const int row = row0 + ai * HALF + m * 16;
                    gq[m][bj] = *(const v2u*)(Zg + (size_t)row * ZPB + col0 + bj * HALF);
                    if (br != 0) mo[m][bj] = *(const u32x4*)(Mg + tl(row, col0 + bj * HALF, DM)); }
            asm volatile("" ::: "memory");
#pragma unroll
            for (int m = 0; m < 4; ++m) {
                const int row = row0 + ai * HALF + m * 16;
#pragma unroll
                for (int bj = 0; bj < 2; ++bj) {
                    float g[8], o[8];
                    { const v2u q = gq[m][bj]; const float k = 1.0f / 255.0f;
                      g[0] = (float)(q.x & 255u) * k; g[1] = (float)((q.x >> 8) & 255u) * k; g[2] = (float)((q.x >> 16) & 255u) * k; g[3] = (float)(q.x >> 24) * k;
                      g[4] = (float)(q.y & 255u) * k; g[5] = (float)((q.y >> 8) & 255u) * k; g[6] = (float)((q.y >> 16) & 255u) * k; g[7] = (float)(q.y >> 24) * k; }
#pragma unroll
                    for (int n = 0; n < 2; ++n)
#pragma unroll
                        for (int i = 0; i < 4; ++i) o[n * 4 + i] = g[n * 4 + i] * acc[ai][bj][m][n][i];
                    if (br != 0) { float p[8]; unpack8(mo[m][bj], p);
#pragma unroll
                        for (int i = 0; i < 8; ++i) o[i] += p[i]; }
                    *(u32x4*)(Mg + tl(row, col0 + bj * HALF, DM)) = pack8(o);
                }
            }
            asm volatile("" ::: "memory");
        }
    }
};
struct MergeOrder {
    StaticOrder base;
    __device__ void init(int M, int N, int G_, int c_) { base.init(M, N, G_, c_); }
    __device__ bool next(int i, Unit& u) const { Unit t; if (!base.next(i >> 2, t)) return false; const int br = i & 3; u.pm = br * 64 + t.pm; u.pn = br * 4 + t.pn; return true; }
    __device__ __forceinline__ void a_ready(const Unit&) const {}
    __device__ __forceinline__ void done(const Unit&) const {}
};
}

__device__ __forceinline__ int map_w13(int n) { const int u = n >= FF ? 1 : 0; const int j = n - u * FF; return 256 * (j >> 7) + 128 * u + (j & 127); }
__device__ __forceinline__ int map_win(int n) {
    if (n < 1280) return n;
    if (n < 1288) return 23 * 256 + (n - 1280);
    if (n < 2312) { const int c = n - 1288, tile = 5 + (c >> 8), cl = c & 255, hh = cl >> 6, r = cl & 63; return tile * 256 + (r >> 5) * 128 + hh * 32 + (r & 31); }
    if (n < 2824) return 9 * 256 + (n - 2312);
    return 11 * 256 + (n - 2824);
}
template <int MAP> __device__ __forceinline__ void transpose_item(const float* __restrict__ W, const float* __restrict__ gk, int K, int N, u16* __restrict__ WT, LAS float* scr, int item, int lane) {
    const int nblk = (N + 31) >> 5, kb = item / nblk, nb = item - kb * nblk, k0 = 64 * kb, n0 = 32 * nb;
    const int nn = n0 + (lane & 31); const bool ok = nn < N;
    float wv[32];
#pragma unroll
    for (int i = 0; i < 32; ++i) { const int kk = 2 * i + (lane >> 5); wv[i] = ok ? W[(size_t)(k0 + kk) * N + nn] : 0.f; }
#pragma unroll
    for (int i = 0; i < 32; ++i) { const int kk = 2 * i + (lane >> 5); float w = wv[i]; if (gk) w *= gk[k0 + kk]; scr[kk * 33 + (lane & 31)] = w; }
    asm volatile("s_waitcnt lgkmcnt(0)" ::: "memory");
    const int c = lane & 7;
#pragma unroll
    for (int j = 0; j < 4; ++j) { const int n = (lane >> 3) + 8 * j; const LAS float* s = scr + (8 * c) * 33 + n;
        if (n0 + n < N) {
            const int dest = MAP == 1 ? map_w13(n0 + n) : (MAP == 2 ? map_win(n0 + n) : (n0 + n));
            v4u o; o.x = pk2(s[0 * 33], s[1 * 33]); o.y = pk2(s[2 * 33], s[3 * 33]); o.z = pk2(s[4 * 33], s[5 * 33]); o.w = pk2(s[6 * 33], s[7 * 33]);
            *(v4u*)(WT + tl(dest, k0 + 8 * c, K)) = o; } }
    asm volatile("s_waitcnt lgkmcnt(0)" ::: "memory");
}

struct Args { const void* in[23]; float* out; unsigned char* ws; };

__device__ __forceinline__ void prologue(const Args& A, unsigned char* ws, LAS unsigned char* lds, int gw, int NGW, int wave, int lane) {
    LAS float* scr = (LAS float*)(lds + wave * 16384);
    int base = 0;
    for (int l = 0; l < NLAYER; ++l) {
        unsigned char* wl = ws + WS_W + (size_t)l * W_LSTRIDE;
        const float* n1 = (const float*)A.in[2] + l * DM; const float* nm = (const float*)A.in[5] + l * DM; const float* n2 = (const float*)A.in[19] + l * DM;
        { const int nit = 16 * 176; for (int it = (gw - base + NGW) % NGW; it < nit; it += NGW) transpose_item<1>((const float*)A.in[3] + (size_t)l * DM * 2 * FF, n1, DM, 2 * FF, (u16*)(wl + WO_13A), scr, it, lane); base = (base + nit) % NGW; }
        { const int nit = 44 * 32;  for (int it = (gw - base + NGW) % NGW; it < nit; it += NGW) transpose_item<0>((const float*)A.in[4] + (size_t)l * FF * DM, nullptr, FF, DM, (u16*)(wl + WO_2A), scr, it, lane); base = (base + nit) % NGW; }
        { const int nit = 16 * 185; for (int it = (gw - base + NGW) % NGW; it < nit; it += NGW) transpose_item<2>((const float*)A.in[6] + (size_t)l * DM * NIN, nm, DM, NIN, (u16*)(wl + WO_IN), scr, it, lane); base = (base + nit) % NGW; }
        { const int nit = 4 * 32;   for (int it = (gw - base + NGW) % NGW; it < nit; it += NGW) transpose_item<0>((const float*)A.in[15] + (size_t)l * 256 * DM, nullptr, 256, DM, (u16*)(wl + WO_PA), scr, it, lane); base = (base + nit) % NGW; }
        { const int nit = 4 * 32;   for (int it = (gw - base + NGW) % NGW; it < nit; it += NGW) transpose_item<0>((const float*)A.in[16] + (size_t)l * 256 * DM, nullptr, 256, DM, (u16*)(wl + WO_PB), scr, it, lane); base = (base + nit) % NGW; }
        { const int nit = 4 * 32;   for (int it = (gw - base + NGW) % NGW; it < nit; it += NGW) transpose_item<0>((const float*)A.in[17] + (size_t)l * 512 * DM, nullptr, 256, DM, (u16*)(wl + WO_PC), scr, it, lane); base = (base + nit) % NGW; }
        { const int nit = 4 * 32;   for (int it = (gw - base + NGW) % NGW; it < nit; it += NGW) transpose_item<0>((const float*)A.in[17] + (size_t)l * 512 * DM + (size_t)256 * DM, nullptr, 256, DM, (u16*)(wl + WO_PC + 512 * KiB), scr, it, lane); base = (base + nit) % NGW; }
        { const int nit = 16 * 32;  for (int it = (gw - base + NGW) % NGW; it < nit; it += NGW) transpose_item<0>((const float*)A.in[18] + (size_t)l * DM * DM, nullptr, DM, DM, (u16*)(wl + WO_OUT), scr, it, lane); base = (base + nit) % NGW; }
        { const int nit = 16 * 176; for (int it = (gw - base + NGW) % NGW; it < nit; it += NGW) transpose_item<1>((const float*)A.in[20] + (size_t)l * DM * 2 * FF, n2, DM, 2 * FF, (u16*)(wl + WO_13B), scr, it, lane); base = (base + nit) % NGW; }
        { const int nit = 44 * 32;  for (int it = (gw - base + NGW) % NGW; it < nit; it += NGW) transpose_item<0>((const float*)A.in[21] + (size_t)l * FF * DM, nullptr, FF, DM, (u16*)(wl + WO_2B), scr, it, lane); base = (base + nit) % NGW; }
        { u16* z0 = (u16*)(wl + WO_IN) + (size_t)23 * 256 * DM; const int nch = 16 * 248 * 8;
          for (int i = gw * 64 + lane; i < nch; i += NGW * 64) { const int kb = i / (248 * 8), r = i - kb * (248 * 8); *(v4u*)(z0 + (size_t)kb * (256 * 64) + 8 * 64 + (size_t)r * 8) = (v4u){0u, 0u, 0u, 0u}; } }
    }
    const float* x = (const float*)A.in[0]; const int* pos = (const int*)A.in[1];
    u16* xb = (u16*)(ws + WS_XB); float* ssp = (float*)(ws + WS_SSP); float* cosT = (float*)(ws + WS_COS); float* sinT = (float*)(ws + WS_SIN);
    for (int row = gw; row < MROWS; row += NGW) {
        const v4f* xr = (const v4f*)(x + (size_t)row * DM) + lane; v4f v[4]; float s = 0.f;
#pragma unroll
        for (int j = 0; j < 4; ++j) { v[j] = xr[64 * j]; s += (v[j].x * v[j].x + v[j].y * v[j].y) + (v[j].z * v[j].z + v[j].w * v[j].w); }
        s = wave_sum(s, lane);
#pragma unroll
        for (int j = 0; j < 4; ++j) { v2u w; w.x = pk2(v[j].x, v[j].y); w.y = pk2(v[j].z, v[j].w); *(v2u*)(xb + tl(row, 4 * lane + 256 * j, DM)) = w; }
        if (lane < 16) ssp[(size_t)row * 16 + lane] = lane == 0 ? s : 0.f;
        if (lane < 32) { const float inv = 1.0f / powf(10000.0f, (float)lane * (1.0f / 32.0f)); const float ang = (float)pos[row] * inv; cosT[(size_t)row * 32 + lane] = cosf(ang); sinT[(size_t)row * 32 + lane] = sinf(ang); }
    }
}

#define LBAR() do { asm volatile("s_waitcnt lgkmcnt(0)" ::: "memory"); __builtin_amdgcn_s_barrier(); asm volatile("" ::: "memory"); } while (0)
constexpr int CWL_OFF = 100 * 1024;
__device__ __forceinline__ void stage_conv_weights(const float* cw, const float* cb, LAS unsigned char* lds, int tid) {
    LAS float* L = (LAS float*)(lds + CWL_OFF);
    const float a0 = cw[tid], a1 = cw[tid + 512], a2 = cw[tid + 1024], a3 = cw[tid + 1536], b0 = cb[tid & 511];
    L[tid] = a0; L[tid + 512] = a1; L[tid + 1024] = a2; L[tid + 1536] = a3; L[2048 + (tid & 511)] = b0;
    LBAR();
}
struct PoolIn { v4u u0, u1; v4f w0, w1; };
__device__ __forceinline__ PoolIn pool_load(const u16* Z, const float* pw, int un, int tid) {
    const int g = un >> 8, tb = un & 63, bl = (un >> 6) & 3; const int r0 = bl * SEQ + tb * 64;
    const int rr = tid >> 3, cg8 = (tid & 7) * 8;
    PoolIn I; const bool ok0 = tb * 64 - 16 + rr >= 0;
    I.u0 = *(const v4u*)(Z + (size_t)(ok0 ? r0 - 16 + rr : r0) * ZP + g * 64 + cg8);
    I.u1 = *(const v4u*)(Z + (size_t)(r0 + 48 + (rr & 15)) * ZP + g * 64 + cg8);
    I.w0 = *(const v4f*)(pw + g * 4096 + tid * 8); I.w1 = *(const v4f*)(pw + g * 4096 + tid * 8 + 4);
    return I;
}
__device__ __forceinline__ void pool_compute(const PoolIn& I, u16* YA, const float* pscale, LAS unsigned char* lds, int un, int tid) {
    const int g = un >> 8, tb = un & 63, bl = (un >> 6) & 3; const int r0 = bl * SEQ + tb * 64;
    constexpr int PLP = 72;
    LAS float* Uf = (LAS float*)lds;
    LAS u16* Pb = (LAS u16*)(lds + 20800);
    LAS u16* WgT = Pb + 64 * PLP;
    const int rr = tid >> 3, cg8 = (tid & 7) * 8, lane = tid & 63, wave = tid >> 6;
    { float x[8]; unpack8(I.u0, x); const float keep0 = tb * 64 - 16 + rr >= 0 ? 1.0f : 0.0f;
#pragma unroll
      for (int i = 0; i < 8; ++i) Uf[rr * 65 + cg8 + i] = x[i] * keep0;
      if (rr < 16) { unpack8(I.u1, x);
#pragma unroll
        for (int i = 0; i < 8; ++i) Uf[(rr + 64) * 65 + cg8 + i] = x[i]; }
      const float wv[8] = {I.w0.x, I.w0.y, I.w0.z, I.w0.w, I.w1.x, I.w1.y, I.w1.z, I.w1.w};
#pragma unroll
      for (int i = 0; i < 8; ++i) WgT[(cg8 + i) * PLP + rr] = (u16)f2bf(wv[i]); }
    LBAR();
    { const int w = 2 << g, t = rr, tpos = tb * 64 + t; const float rc = 1.0f / (float)(tpos + 1 < w ? tpos + 1 : w);
        float s[8], u0[8];
#pragma unroll
        for (int i = 0; i < 8; ++i) { u0[i] = Uf[(16 + t) * 65 + cg8 + i]; s[i] = u0[i] + Uf[(15 + t) * 65 + cg8 + i]; }
        if (g >= 1) {
#pragma unroll
            for (int i = 0; i < 8; ++i) s[i] += Uf[(14 + t) * 65 + cg8 + i] + Uf[(13 + t) * 65 + cg8 + i]; }
        if (g >= 2) {
#pragma unroll
            for (int i = 0; i < 8; ++i) s[i] += (Uf[(12 + t) * 65 + cg8 + i] + Uf[(11 + t) * 65 + cg8 + i]) + (Uf[(10 + t) * 65 + cg8 + i] + Uf[(9 + t) * 65 + cg8 + i]); }
        if (g >= 3) {
#pragma unroll
            for (int i = 0; i < 8; ++i) { float a = 0.f;
#pragma unroll
                for (int j = 8; j < 16; ++j) a += Uf[(16 + t - j) * 65 + cg8 + i];
                s[i] += a; } }
        float p[8];
#pragma unroll
        for (int i = 0; i < 8; ++i) p[i] = s[i] * rc - u0[i];
        *(LAS v4u*)(Pb + t * PLP + cg8) = pack8(p); }
    LBAR();
    {
        const int tr = wave >> 1, tc0 = (wave & 1) * 2, fr = lane & 15, fq = lane >> 4;
        v4f a0 = {0.f, 0.f, 0.f, 0.f}, a1 = {0.f, 0.f, 0.f, 0.f};
#pragma unroll
        for (int kk = 0; kk < 2; ++kk) { const v8s a = *(const LAS v8s*)(Pb + (16 * tr + fr) * PLP + 32 * kk + 8 * fq);
            a0 = __builtin_amdgcn_mfma_f32_16x16x32_bf16(a, *(const LAS v8s*)(WgT + (16 * tc0 + fr) * PLP + 32 * kk + 8 * fq), a0, 0, 0, 0);
            a1 = __builtin_amdgcn_mfma_f32_16x16x32_bf16(a, *(const LAS v8s*)(WgT + (16 * tc0 + 16 + fr) * PLP + 32 * kk + 8 * fq), a1, 0, 0, 0); }
#pragma unroll
        for (int rg = 0; rg < 4; ++rg) { const int t = 16 * tr + 4 * fq + rg; Uf[t * 65 + 16 * tc0 + fr] = a0[rg]; Uf[t * 65 + 16 * tc0 + 16 + fr] = a1[rg]; } }
    LBAR();
    { const int t = rr; float o[8];
#pragma unroll
        for (int i = 0; i < 8; ++i) o[i] = Uf[t * 65 + cg8 + i] * pscale[g * 64 + cg8 + i];
        *(v4u*)(YA + tl(r0 + t, g * 64 + cg8, 256)) = pack8(o); }
    LBAR();
}

__device__ __forceinline__ void conv8r(const v4u* rows, const LAS float* cwL, int ch0, float* o, int tpos) {
#pragma unroll
    for (int i = 0; i < 8; ++i) o[i] = cwL[2048 + ch0 + i];
#pragma unroll
    for (int j = 0; j < 4; ++j) { float x[8]; unpack8(rows[j], x); const float keep = tpos - 3 + j >= 0 ? 1.0f : 0.0f;
#pragma unroll
        for (int i = 0; i < 8; ++i) o[i] += cwL[j * 512 + ch0 + i] * (x[i] * keep); }
#pragma unroll
    for (int i = 0; i < 8; ++i) o[i] = siluf_(o[i]);
}
__device__ __forceinline__ void load4rows(const u16* Z, int r, int tpos, int zcol, v4u* rows) {
#pragma unroll
    for (int j = 0; j < 4; ++j) { const bool ok = tpos - 3 + j >= 0; rows[j] = *(const v4u*)(Z + (size_t)(ok ? r - 3 + j : r) * ZP + zcol); }
}
constexpr int LP = 72;
__device__ __forceinline__ v8s lds_frag(const LAS u16* base, int row, int koff) { return *(const LAS v8s*)(base + row * LP + koff); }

struct M1In { v4u k[4]; v4u v; float ip, fp; };
__device__ __forceinline__ M1In m1_load(const u16* Z, const float* mif, int un, int tid) {
    const int c = un & 63, h = (un >> 6) & 3, bl = un >> 8; const int r0 = bl * SEQ + c * 64;
    const int s = tid >> 3, dg = tid & 7;
    M1In I; load4rows(Z, r0 + s, c * 64 + s, 2 * 256 + h * 64 + dg * 8, I.k);
    I.v = *(const v4u*)(Z + (size_t)(r0 + s) * ZP + 3 * 256 + h * 64 + dg * 8);
    I.ip = mif[(size_t)(r0 + (tid & 63)) * 8 + h]; I.fp = mif[(size_t)(r0 + (tid & 63)) * 8 + 4 + h];
    return I;
}
__device__ __forceinline__ void m1_compute(const M1In& I, float* U, float* nU, float* mlv, float* blv, LAS unsigned char* lds, int un, int tid) {
    const int h = (un >> 6) & 3;
    const int lane = tid & 63, wave = tid >> 6;
    LAS float* wk = (LAS float*)lds;
    LAS u16* Vt = (LAS u16*)(lds + 1024);
    LAS u16* KWt = Vt + 64 * LP;
    const LAS float* cwL = (const LAS float*)(lds + CWL_OFF);
    if (wave == 0) {
        const float bc = wave_incl_sum(logsigmoidf_(I.fp), lane); const float blast = lane63_(bc);
        const float g = blast - bc + I.ip; const float mx = wave_max(g, lane);
        wk[lane] = __expf(g - mx);
        if (lane == 0) { wk[64] = mx; wk[65] = blast; }
    }
    const int s = tid >> 3, dg = tid & 7;
    float kv[8]; conv8r(I.k, cwL, 256 + h * 64 + dg * 8, kv, (un & 63) * 64 + s);
    float vv[8]; unpack8(I.v, vv);
    LBAR();
    { const float w = wk[s] * 0.125f;
#pragma unroll
        for (int i = 0; i < 8; ++i) { KWt[(dg * 8 + i) * LP + s] = (u16)f2bf(kv[i] * w); Vt[(dg * 8 + i) * LP + s] = (u16)f2bf(vv[i]); } }
    LBAR();
    { const int tr = wave >> 1, tc0 = (wave & 1) * 2, fr = lane & 15, fq = lane >> 4;
        v4f a0 = {0.f, 0.f, 0.f, 0.f}, a1 = {0.f, 0.f, 0.f, 0.f};
#pragma unroll
        for (int kk = 0; kk < 2; ++kk) { const v8s a = lds_frag(Vt, 16 * tr + fr, 32 * kk + 8 * fq);
            a0 = __builtin_amdgcn_mfma_f32_16x16x32_bf16(a, lds_frag(KWt, 16 * tc0 + fr, 32 * kk + 8 * fq), a0, 0, 0, 0);
            a1 = __builtin_amdgcn_mfma_f32_16x16x32_bf16(a, lds_frag(KWt, 16 * tc0 + 16 + fr, 32 * kk + 8 * fq), a1, 0, 0, 0); }
        float* Uo = U + (size_t)un * 4096;
#pragma unroll
        for (int rg = 0; rg < 4; ++rg) { const int e = 16 * tr + 4 * fq + rg; Uo[e * 64 + 16 * tc0 + fr] = a0[rg]; Uo[e * 64 + 16 * tc0 + 16 + fr] = a1[rg]; } }
    { float x[8]; unpack8(*(const LAS v4u*)(KWt + s * LP + dg * 8), x); float sN = ((x[0] + x[1]) + (x[2] + x[3])) + ((x[4] + x[5]) + (x[6] + x[7]));
      sN = red8(sN); if (dg == 0) nU[un * 64 + s] = sN; }
    if (tid == 0) { mlv[un] = wk[64]; blv[un] = wk[65]; }
    LBAR();
}

__device__ __forceinline__ void m2_phase(const float* __restrict__ U, const float* __restrict__ nU, const float* __restrict__ mlv, const float* __restrict__ blv,
                                         u16* __restrict__ Cst, float* __restrict__ nst, float* __restrict__ mst, LAS unsigned char* lds, int G, int bx, int tid) {
    const int per = (16 * 4160 + G - 1) / G, e0 = bx * per;
    const int pfirst = e0 / 4160;
    LAS float* decs = (LAS float*)lds; LAS float* scs = decs + 128;
    const int lane = tid & 63, wave = tid >> 6;
    if (wave < 2 && pfirst + wave < 16) {
        const int un = (pfirst + wave) * 64 + lane; const float ml = mlv[un], b = blv[un];
        const float Bincl = wave_incl_sum(b, lane);
        const float Mnext = fmaxf(0.f, wave_incl_max(ml - Bincl, lane));
        float Mcur = shl_(Mnext, (lane - 1) & 63); if (lane == 0) Mcur = 0.f;
        const float mcur = Mcur + (Bincl - b), mnext = Mnext + Bincl;
        decs[wave * 64 + lane] = __expf(b + mcur - mnext); scs[wave * 64 + lane] = __expf(ml - mnext);
        mst[un] = mcur;
    }
    LBAR();
    for (int t = tid; t < per; t += NTHR) { const int gt = e0 + t; if (gt < 16 * 4160) {
        const int p = gt / 4160, idx = gt - p * 4160, w = (p - pfirst) * 64; float st = 0.f;
        if (idx < 4096) { const float* up = U + (size_t)p * 64 * 4096 + idx; u16* cp = Cst + (size_t)p * 64 * 4096 + idx;
            float uv[64];
#pragma unroll
            for (int c = 0; c < 64; ++c) uv[c] = up[(size_t)c * 4096];
#pragma unroll
            for (int c = 0; c < 64; ++c) { cp[(size_t)c * 4096] = (u16)f2bf(st); st = decs[w + c] * st + scs[w + c] * uv[c]; } }
        else { const float* up = nU + p * 64 * 64 + idx - 4096; float* np = nst + p * 64 * 64 + idx - 4096;
            float uv[64];
#pragma unroll
            for (int c = 0; c < 64; ++c) uv[c] = up[c * 64];
            asm volatile("" ::: "memory");
#pragma unroll
            for (int c = 0; c < 64; ++c) { np[c * 64] = st; st = decs[w + c] * st + scs[w + c] * uv[c]; } } } }
    LBAR();
}

struct M3In { v4u q[4], k[4], v, c, mo; float ip, fp, nvv, mc; };
__device__ __forceinline__ M3In m3_load(const u16* Z, const float* mif, const u16* Cst, const float* nst, const float* mst, int un, int tid) {
    const int c = un & 63, h = (un >> 6) & 3, bl = un >> 8; const int r0 = bl * SEQ + c * 64;
    const int s = tid >> 3, dg = tid & 7;
    M3In I; load4rows(Z, r0 + s, c * 64 + s, 1 * 256 + h * 64 + dg * 8, I.q); load4rows(Z, r0 + s, c * 64 + s, 2 * 256 + h * 64 + dg * 8, I.k);
    I.v = *(const v4u*)(Z + (size_t)(r0 + s) * ZP + 3 * 256 + h * 64 + dg * 8);
    I.mo = *(const v4u*)(Z + (size_t)(r0 + s) * ZP + 4 * 256 + h * 64 + dg * 8);
    I.c = *(const v4u*)(Cst + (size_t)un * 4096 + s * 64 + dg * 8);
    I.ip = mif[(size_t)(r0 + (tid & 63)) * 8 + h]; I.fp = mif[(size_t)(r0 + (tid & 63)) * 8 + 4 + h]; I.nvv = nst[un * 64 + (tid & 63)]; I.mc = mst[un];
    return I;
}
__device__ __forceinline__ void m3_compute(const M3In& I, const float* mnorm, u16* YB, LAS unsigned char* lds, int un, int tid) {
    const int c = un & 63, h = (un >> 6) & 3, bl = un >> 8; const int r0 = bl * SEQ + c * 64;
    const int lane = tid & 63, wave = tid >> 6;
    LAS float* av = (LAS float*)lds;
    LAS float* Mx = av + 64;
    LAS float* wi = Mx + 64;
    LAS float* emt = wi + 64;
    LAS float* nv = emt + 64;
    LAS float* dinv = nv + 64;
    LAS u16* Qs = (LAS u16*)(lds + 2048);
    LAS u16* Ks = Qs + 64 * LP;
    LAS u16* Vt = Ks + 64 * LP;
    LAS u16* Cs = Vt + 64 * LP;
    LAS u16* SC = Cs + 64 * LP;
    LAS float* NUM = (LAS float*)(SC + 64 * LP);
    const LAS float* cwL = (const LAS float*)(lds + CWL_OFF);
    if (wave == 0) {
        const float mc = I.mc;
        const float bc = wave_incl_sum(logsigmoidf_(I.fp), lane);
        const float a = I.ip - bc; const float pm = wave_incl_max(a, lane); const float MM = fmaxf(mc, pm);
        av[lane] = a; Mx[lane] = MM; wi[lane] = __expf(mc - MM); emt[lane] = __expf(-bc - MM); nv[lane] = I.nvv;
    }
    const int s = tid >> 3, dg = tid & 7;
    { float q[8], k[8], v[8];
        conv8r(I.q, cwL, h * 64 + dg * 8, q, c * 64 + s);
        conv8r(I.k, cwL, 256 + h * 64 + dg * 8, k, c * 64 + s);
#pragma unroll
        for (int i = 0; i < 8; ++i) k[i] *= 0.125f;
        unpack8(I.v, v);
        *(LAS v4u*)(Qs + s * LP + dg * 8) = pack8(q);
        *(LAS v4u*)(Ks + s * LP + dg * 8) = pack8(k);
#pragma unroll
        for (int i = 0; i < 8; ++i) Vt[(dg * 8 + i) * LP + s] = (u16)f2bf(v[i]);
        *(LAS v4u*)(Cs + s * LP + dg * 8) = I.c; }
    LBAR();
    const int tr = wave >> 1, tc0 = (wave & 1) * 2, fr = lane & 15, fq = lane >> 4;
    {
        v4f a0 = {0.f, 0.f, 0.f, 0.f}, a1 = {0.f, 0.f, 0.f, 0.f};
#pragma unroll
        for (int kk = 0; kk < 2; ++kk) { const v8s a = lds_frag(Qs, 16 * tr + fr, 32 * kk + 8 * fq);
            a0 = __builtin_amdgcn_mfma_f32_16x16x32_bf16(a, lds_frag(Ks, 16 * tc0 + fr, 32 * kk + 8 * fq), a0, 0, 0, 0);
            a1 = __builtin_amdgcn_mfma_f32_16x16x32_bf16(a, lds_frag(Ks, 16 * tc0 + 16 + fr, 32 * kk + 8 * fq), a1, 0, 0, 0); }
#pragma unroll
        for (int rg = 0; rg < 4; ++rg) { const int t = 16 * tr + 4 * fq + rg; const float mt = Mx[t];
            const int s0 = 16 * tc0 + fr, s1 = s0 + 16;
            const float w0 = s0 <= t ? __expf(av[s0] - mt) : 0.f, w1 = s1 <= t ? __expf(av[s1] - mt) : 0.f;
            SC[t * LP + s0] = (u16)f2bf(a0[rg] * w0); SC[t * LP + s1] = (u16)f2bf(a1[rg] * w1); } }
    LBAR();
    {
        v4f a0 = {0.f, 0.f, 0.f, 0.f}, a1 = {0.f, 0.f, 0.f, 0.f}, c0 = {0.f, 0.f, 0.f, 0.f}, c1 = {0.f, 0.f, 0.f, 0.f};
#pragma unroll
        for (int kk = 0; kk < 2; ++kk) { const v8s a = lds_frag(SC, 16 * tr + fr, 32 * kk + 8 * fq), q = lds_frag(Qs, 16 * tr + fr, 32 * kk + 8 * fq);
            a0 = __builtin_amdgcn_mfma_f32_16x16x32_bf16(a, lds_frag(Vt, 16 * tc0 + fr, 32 * kk + 8 * fq), a0, 0, 0, 0);
            a1 = __builtin_amdgcn_mfma_f32_16x16x32_bf16(a, lds_frag(Vt, 16 * tc0 + 16 + fr, 32 * kk + 8 * fq), a1, 0, 0, 0);
            c0 = __builtin_amdgcn_mfma_f32_16x16x32_bf16(q, lds_frag(Cs, 16 * tc0 + fr, 32 * kk + 8 * fq), c0, 0, 0, 0);
            c1 = __builtin_amdgcn_mfma_f32_16x16x32_bf16(q, lds_frag(Cs, 16 * tc0 + 16 + fr, 32 * kk + 8 * fq), c1, 0, 0, 0); }
#pragma unroll
        for (int rg = 0; rg < 4; ++rg) { const int t = 16 * tr + 4 * fq + rg; const float w = wi[t];
            NUM[t * 65 + 16 * tc0 + fr] = a0[rg] + w * c0[rg]; NUM[t * 65 + 16 * tc0 + 16 + fr] = a1[rg] + w * c1[rg]; } }
    { const int t = s; float a[8], q[8]; unpack8(*(const LAS v4u*)(SC + t * LP + dg * 8), a); unpack8(*(const LAS v4u*)(Qs + t * LP + dg * 8), q);
        float rs = ((a[0] + a[1]) + (a[2] + a[3])) + ((a[4] + a[5]) + (a[6] + a[7])), qn = 0.f;
#pragma unroll
        for (int i = 0; i < 8; ++i) qn += q[i] * nv[dg * 8 + i];
        rs = red8(rs); qn = red8(qn);
        if (dg == 0) { const float den = rs + wi[t] * qn; dinv[t] = 1.0f / fmaxf(fabsf(den), emt[t]); } }
    LBAR();
    {
        const int t = s; const float di = dinv[t]; float hv[8]; float sm = 0.f;
#pragma unroll
        for (int i = 0; i < 8; ++i) { hv[i] = NUM[t * 65 + dg * 8 + i] * di; sm += hv[i]; }
        sm = red8(sm);
        const float mu = sm * (1.0f / 64.0f); float vs = 0.f;
#pragma unroll
        for (int i = 0; i < 8; ++i) { hv[i] -= mu; vs += hv[i] * hv[i]; }
        vs = red8(vs);
        const float rstd = rsqrtf(vs * (1.0f / 64.0f) + EPS);
        float og[8]; unpack8(I.mo, og);
        float o[8];
#pragma unroll
        for (int i = 0; i < 8; ++i) o[i] = hv[i] * rstd * mnorm[h * 64 + dg * 8 + i] * sigmoidf_(og[i]);
        *(v4u*)(YB + tl(r0 + t, h * 64 + dg * 8, 256)) = pack8(o); }
    LBAR();
}

__device__ __forceinline__ void attn_post(const u16* O, u16* YC, const float* dlam, const float* dnorm, float lambda_init, int gt, int nthreads, int lane) {
    float sa = dlam[lane] * dlam[64 + lane], sb = dlam[128 + lane] * dlam[192 + lane];
    sa = wave_sum(sa, lane); sb = wave_sum(sb, lane);
    const float lam = expf(sa) - expf(sb) + lambda_init, post = 1.0f - lambda_init;
    const int sub = gt & 15;
    float gn[8];
#pragma unroll
    for (int i = 0; i < 8; ++i) gn[i] = dnorm[sub * 8 + i] * post;
    const int stride = nthreads >> 4;
    for (int item0 = gt >> 4; item0 < MH * 4; item0 += 8 * stride) {
        v4u ra[8], rb[8];
#pragma unroll
        for (int q = 0; q < 8; ++q) { const int item = item0 + q * stride < MH * 4 ? item0 + q * stride : item0; const int row = item >> 2, hh = item & 3;
            ra[q] = *(const v4u*)(O + (size_t)row * 1024 + (2 * hh) * 128 + sub * 8); rb[q] = *(const v4u*)(O + (size_t)row * 1024 + (2 * hh + 1) * 128 + sub * 8); }
#pragma unroll
        for (int q = 0; q < 8; ++q) { const int item = item0 + q * stride; const int row = item >> 2, hh = item & 3; float a[8], b[8], d[8]; float ss = 0.f;
            unpack8(ra[q], a); unpack8(rb[q], b);
#pragma unroll
            for (int i = 0; i < 8; ++i) { d[i] = a[i] - lam * b[i]; ss += d[i] * d[i]; }
            ss = red16(ss);
            const float r = rsqrtf(ss * (1.0f / 128.0f) + EPS);
#pragma unroll
            for (int i = 0; i < 8; ++i) d[i] *= r * gn[i];
            if (item < MH * 4) *(v4u*)(YC + (size_t)(hh >> 1) * MH * 256 + tl(row, (hh & 1) * 128 + sub * 8, 256)) = pack8(d); }
    }
}

#define RLX_AGENT __ATOMIC_RELAXED, __HIP_MEMORY_SCOPE_AGENT
#define XB_TMO      128
#define XB_XCNT(j)  (256  + 64 * (j))
#define XB_XSUB(j)  (1280 + 64 * (j))
#define XB_XGEN(j)  (2304 + 64 * (j))
#define XB_TOP      3328
#define XB_TOPGEN   3392
#define XCD_BAR_WORDS 3456
#define XB_SPIN_CAP (1u << 18)

__device__ __forceinline__ unsigned xb_ld(unsigned* p)              { return __hip_atomic_load(p, __ATOMIC_RELAXED, __HIP_MEMORY_SCOPE_AGENT); }
__device__ __forceinline__ unsigned xb_add(unsigned* p, unsigned v) { return __hip_atomic_fetch_add(p, v, __ATOMIC_RELAXED, __HIP_MEMORY_SCOPE_AGENT); }
__device__ __forceinline__ unsigned xb_xcc_id() { return (unsigned)__builtin_amdgcn_s_getreg((3 << 11) | 20) & 0xFu; }
#define XB_SPIN(cond, bar) do { unsigned _sp = 0; while (cond) { __builtin_amdgcn_s_sleep(1); \
    if ((++_sp & 255u) == 0u) { if (xb_ld(&(bar)[XB_TMO])) break; if (_sp > XB_SPIN_CAP) { atomicAdd(&(bar)[XB_TMO], 1u); break; } } } } while (0)

struct XcdBarrier {
    unsigned* bar; unsigned x;
    volatile LAS unsigned* st;
};

__device__ __forceinline__ XcdBarrier xcd_barrier_post(unsigned* bar, volatile LAS unsigned* st) {
    XcdBarrier b; b.bar = bar; b.x = xb_xcc_id(); b.st = st;
    if (threadIdx.x == 0) (void)xb_add(&bar[XB_XCNT(b.x)], 1u);
    return b;
}
__device__ __forceinline__ void xcd_barrier_complete(unsigned* bar, unsigned x, unsigned& nloc, unsigned& nx) {
    const unsigned G = gridDim.x * gridDim.y * gridDim.z;
    unsigned sum, cnt, mine, sp = 0u;
    for (;;) {
        sum = 0u; cnt = 0u; mine = 0u;
#pragma unroll
        for (unsigned j = 0; j < 16; ++j) { const unsigned c = xb_ld(&bar[XB_XCNT(j)]); sum += c; cnt += (c > 0u) ? 1u : 0u; mine = (j == x) ? c : mine; }
        if (sum == G) break;
        __builtin_amdgcn_s_sleep(1);
        if ((++sp & 255u) == 0u) { if (xb_ld(&bar[XB_TMO])) break; if (sp > XB_SPIN_CAP) { atomicAdd(&bar[XB_TMO], 1u); break; } }
    }
    nloc = mine > 0u ? mine : 1u; nx = cnt > 0u ? cnt : 1u;
}

__device__ __forceinline__ void xcd_barrier(const XcdBarrier& b) {
    asm volatile("s_waitcnt vmcnt(0)" ::: "memory");
    __syncthreads();
    if (threadIdx.x == 0) {
        unsigned* bar = b.bar;
        __builtin_amdgcn_s_waitcnt(0);
        unsigned nloc = b.st[0], nx = b.st[1];
        if (nloc == 0u) { xcd_barrier_complete(bar, b.x, nloc, nx); b.st[0] = nloc; b.st[1] = nx; }
        const unsigned old = xb_add(&bar[XB_XSUB(b.x)], 1u);
        const unsigned gen = old / nloc;
        if (old + 1u == (gen + 1u) * nloc) {
            __builtin_amdgcn_fence(__ATOMIC_RELEASE, "agent");
            asm volatile("s_waitcnt vmcnt(0)" ::: "memory");
            const unsigned og = xb_add(&bar[XB_TOP], 1u);
            const unsigned tg = og / nx;
            if (og + 1u == (tg + 1u) * nx) xb_add(&bar[XB_TOPGEN], 1u);
            else XB_SPIN(xb_ld(&bar[XB_TOPGEN]) == tg, bar);
            __builtin_amdgcn_fence(__ATOMIC_ACQUIRE, "agent");
            xb_add(&bar[XB_XGEN(b.x)], 1u);
            asm volatile("s_waitcnt vmcnt(0)" ::: "memory");
        } else {
            XB_SPIN(xb_ld(&bar[XB_XGEN(b.x)]) == gen, bar);
            __builtin_amdgcn_fence(__ATOMIC_ACQUIRE, "agent");
            asm volatile("s_waitcnt vmcnt(0)" ::: "memory");
        }
    }
    __syncthreads();
}


#ifndef SK0
#define SK0 0
#endif
#ifndef SK1
#define SK1 0
#endif
#ifndef SK2
#define SK2 0
#endif
#ifndef SK3
#define SK3 0
#endif
#ifndef SK4
#define SK4 0
#endif
#ifndef SK5
#define SK5 0
#endif
#ifndef SK6
#define SK6 0
#endif
#ifndef SKP
#define SKP 0
#endif
#ifndef REPMASK
#define REPMASK 0
#endif
#ifndef REPK1SEL
#define REPK1SEL 0
#endif
#ifndef REPSYNC
#define REPSYNC 0
#endif
#ifndef REPPRO
#define REPPRO 0
#endif
constexpr int PT_OFF = 131072 + 4096, MISC_OFF = 131072 + 8192;
__device__ __forceinline__ unsigned char* rd_ptr(int i) {
    const unsigned long long v = *(const LAS unsigned long long*)(((LAS unsigned char*)0) + PT_OFF + 8 * i);
    const unsigned lo = __builtin_amdgcn_readfirstlane((unsigned)v), hi = __builtin_amdgcn_readfirstlane((unsigned)(v >> 32));
    typedef __attribute__((address_space(1))) unsigned char gbyte;
    gbyte* gp = (gbyte*)(((unsigned long long)hi << 32) | lo);
    return (unsigned char*)gp;
}
__device__ __forceinline__ unsigned char* rd_ptr_generic(int i) {
    const unsigned long long v = *(const LAS unsigned long long*)(((LAS unsigned char*)0) + PT_OFF + 8 * i);
    const unsigned lo = __builtin_amdgcn_readfirstlane((unsigned)v), hi = __builtin_amdgcn_readfirstlane((unsigned)(v >> 32));
    return (unsigned char*)(((unsigned long long)hi << 32) | lo);
}
#define P_IN(i) ((const float*)rd_ptr(i))
#define P_OUT() ((float*)rd_ptr(23))
#define P_WS() (rd_ptr(24))

__global__ void __launch_bounds__(NTHR, 2) trunk_fwd(Args args) {
    extern __shared__ __attribute__((aligned(16))) unsigned char lds_raw[];
    cg::grid_group grid = cg::this_grid();
    LAS unsigned char* lds = (LAS unsigned char*)lds_raw;
    {
        const int tid = threadIdx.x;
        LAS unsigned long long* PT = (LAS unsigned long long*)(lds + PT_OFF);
        if (tid < 23) PT[tid] = (unsigned long long)args.in[tid];
        if (tid == 23) PT[23] = (unsigned long long)args.out;
        if (tid == 24) PT[24] = (unsigned long long)args.ws;
        if (tid < 16) ((LAS unsigned*)(lds + MISC_OFF))[tid] = 0u;
        __syncthreads();
        if (blockIdx.x == 0) { unsigned* bw = (unsigned*)(args.ws + WS_BAR);
            for (int i = tid; i < XCD_BAR_WORDS; i += NTHR) __hip_atomic_store(bw + i, 0u, __ATOMIC_RELAXED, __HIP_MEMORY_SCOPE_AGENT); }
        const int lane = tid & 63, wave = __builtin_amdgcn_readfirstlane(tid >> 6);
        for (int rp_ = 0; rp_ < (REPPRO ? 2 : 1); ++rp_)
        if (!SKP) prologue(args, args.ws, lds, (int)blockIdx.x * NWAVES + wave, (int)gridDim.x * NWAVES, wave, lane);
    }
    grid.sync();
    (void)xcd_barrier_post((unsigned*)(args.ws + WS_BAR), (volatile LAS unsigned*)(lds + MISC_OFF));

    constexpr int NREP = (REPMASK || REPSYNC) ? 2 : 1;
    for (int it_ = 0; it_ < 32 * NREP; ++it_) {
        const int st = it_ / NREP, rep_ = it_ % NREP;
        const int l = st >> 4, s = st & 15;
        int kind, hb = 0;
        if (s == 0 || s == 14) kind = 0; else if (s == 1 || s == 15) kind = 1; else { hb = (s - 2) / 6; kind = 2 + (s - 2) % 6; if (kind == 7) kind = 1; }
        const size_t hrow = (size_t)hb * MH;
        int G = gridDim.x, bx = blockIdx.x; asm volatile("" : "+s"(G), "+s"(bx));
        unsigned char* ws = P_WS();
        unsigned char* wl = ws + WS_W + (size_t)l * W_LSTRIDE;
        if (rep_ == 1 && !(((REPMASK >> kind) & 1) || REPSYNC)) continue;
        if (rep_ == 1 && kind == 1 && REPK1SEL && ((REPK1SEL == 1) != (s == 1 || s == 15))) continue;
        if (!(rep_ == 1 && REPSYNC)) {
        if (kind == 0 && !SK0) {
            pg8::Gemm g{(const u16*)(ws + WS_XB), (const u16*)(wl + (s == 0 ? WO_13A : WO_13B)), MROWS, 2 * FF, DM}; pg8::StaticOrder S; S.init(MROWS, 2 * FF, G, bx);
            pg8::EpiSwiglu E{(u16*)(ws + WS_ZA), (const float*)(ws + WS_SSP)};
            pg8::gemm_phase<pg8::EpiSwiglu, pg8::StaticOrder, PG8_ALIGN, PG8_SP2>(lds, g, S, E);
        } else if (kind == 1 && !SK1) {
            const bool ffn = (s == 1 || s == 15);
            const u16* Aop = (const u16*)(ws + (ffn ? WS_ZA : WS_MG)); const u16* Bop = (const u16*)(wl + (s == 1 ? WO_2A : (s == 15 ? WO_2B : WO_OUT)));
            const int Mr = ffn ? MROWS : MH, K = ffn ? FF : DM;
            const float* x0 = nullptr;
            pg8::Gemm g{Aop, Bop, Mr, DM, K}; pg8::StaticOrder S; S.init(Mr, DM, G, bx);
            pg8::EpiResid E{x0, (u16*)(ws + WS_XB) + hrow * DM, (float*)(ws + WS_SSP) + hrow * 16, rep_ ? 0.0f : (ffn ? 0.5f : 1.0f)};
            pg8::gemm_phase<pg8::EpiResid, pg8::StaticOrder, PG8_ALIGN, PG8_SP2>(lds, g, S, E);
        } else if (kind == 2 && !SK2) {
            pg8::Gemm g{(const u16*)(ws + WS_XB) + hrow * DM, (const u16*)(wl + WO_IN), MH, 24 * 256, DM}; pg8::StaticOrder S; S.init(MH, 24 * 256, G, bx);
            pg8::EpiWin E{(u16*)(ws + WS_ZA), (u16*)(ws + WS_QC), (u16*)(ws + WS_KC), (u16*)(ws + WS_VC), (float*)(ws + WS_MIF), (const float*)(ws + WS_SSP) + hrow * 16, (const float*)(ws + WS_COS) + hrow * 32, (const float*)(ws + WS_SIN) + hrow * 32, P_IN(11) + l * 8};
            pg8::gemm_phase<pg8::EpiWin, pg8::StaticOrder, PG8_ALIGN, PG8_SP2>(lds, g, S, E);
        } else if (kind == 3 && !SK3) {
            int tid = threadIdx.x; asm volatile("" : "+v"(tid));
            stage_conv_weights(P_IN(9) + l * 4 * 512, P_IN(10) + l * 512, lds, tid);
            { const u16* Zp = (const u16*)(ws + WS_ZA); const float* mifp = (const float*)(ws + WS_MIF);
              if (bx < 1024) { M1In cur = m1_load(Zp, mifp, bx, tid);
                for (int un = bx; un < 1024; un += G) { const M1In nxt = m1_load(Zp, mifp, un + G < 1024 ? un + G : un, tid);
                    m1_compute(cur, (float*)(ws + WS_U), (float*)(ws + WS_NU), (float*)(ws + WS_ML), (float*)(ws + WS_BL), lds, un, tid);
                    cur = nxt; } } }
            { const u16* Zp = (const u16*)(ws + WS_ZA); const float* pw = P_IN(7) + l * 4 * 4096; const float* psc = P_IN(8) + l * 256;
              if (bx < 1024) { PoolIn cur = pool_load(Zp, pw, bx, tid);
                for (int un = bx; un < 1024; un += G) { const PoolIn nxt = pool_load(Zp, pw, un + G < 1024 ? un + G : un, tid);
                    pool_compute(cur, (u16*)(ws + WS_YA), psc, lds, un, tid);
                    cur = nxt; } } }
        } else if (kind == 4 && !SK4) {
            { int tid = threadIdx.x; asm volatile("" : "+v"(tid));
              m2_phase((const float*)(ws + WS_U), (const float*)(ws + WS_NU), (const float*)(ws + WS_ML), (const float*)(ws + WS_BL), (u16*)(ws + WS_CST), (float*)(ws + WS_NST), (float*)(ws + WS_MST), lds, G, bx, tid); }
            unsigned char* wsg = rd_ptr_generic(24);
            const int rounds = (512 + G - 1) / G;
            for (int r = 0; r < rounds; ++r) {
                const int p = (r & 1) ? (G - 1 - bx) : bx; const int u = r * G + p;
                if (u < 512) { const int qb = 15 - (u >> 5), pair = u & 31, bl = pair >> 3, j = pair & 7;
                    attn_body::attn_unit<8>(qb, (const attn_body::bf16*)((const u16*)(wsg + WS_QC) + (size_t)(bl * 8 + j) * SEQ * 64), (const attn_body::bf16*)((const u16*)(wsg + WS_KC) + (size_t)(bl * 8 + j) * SEQ * 64),
                                            (const attn_body::bf16*)((const u16*)(wsg + WS_VC) + (size_t)((bl * 4 + (j >> 1)) * 2) * SEQ * 64),
                                            (attn_body::bf16*)((u16*)(wsg + WS_O) + (size_t)(bl * SEQ) * 1024 + j * 128), (char*)lds_raw); }
            }
        } else if (kind == 5 && !SK5) {
            int tid = threadIdx.x; asm volatile("" : "+v"(tid));
            stage_conv_weights(P_IN(9) + l * 4 * 512, P_IN(10) + l * 512, lds, tid);
            { const u16* Zp = (const u16*)(ws + WS_ZA); const float* mifp = (const float*)(ws + WS_MIF); const u16* cstp = (const u16*)(ws + WS_CST); const float* nstp = (const float*)(ws + WS_NST); const float* mstp = (const float*)(ws + WS_MST);
              if (bx < 1024) { M3In cur = m3_load(Zp, mifp, cstp, nstp, mstp, bx, tid);
                for (int un = bx; un < 1024; un += G) { const M3In nxt = m3_load(Zp, mifp, cstp, nstp, mstp, un + G < 1024 ? un + G : un, tid);
                    m3_compute(cur, P_IN(12) + l * 256, (u16*)(ws + WS_YB), lds, un, tid);
                    cur = nxt; } } }
            const float lambda_init = 0.8f - 0.6f * expf(-0.3f * (float)l);
            attn_post((const u16*)(ws + WS_O), (u16*)(ws + WS_YC), P_IN(13) + l * 256, P_IN(14) + l * 128, lambda_init, bx * NTHR + tid, G * NTHR, tid & 63);
        } else if (!SK6) {
            pg8::Gemm g{(const u16*)(ws + WS_YA), (const u16*)(wl + WO_PA), 4 * MH, 4 * DM, 256}; pg8::MergeOrder S; S.init(MH, DM, G, bx);
            pg8::EpiMerge E{(const u16*)(ws + WS_ZA), (u16*)(ws + WS_MG)};
            pg8::gemm_phase<pg8::EpiMerge, pg8::MergeOrder, PG8_ALIGN, PG8_SP2>(lds, g, S, E);
        }
        }
        { XcdBarrier bar; bar.bar = (unsigned*)(P_WS() + WS_BAR); bar.x = xb_xcc_id(); bar.st = (volatile LAS unsigned*)(lds + MISC_OFF); xcd_barrier(bar); }
    }
    { const float* fg = P_IN(22); float* outp = P_OUT(); const u16* xb = (const u16*)(P_WS() + WS_XB);
      int tid = threadIdx.x; asm volatile("" : "+v"(tid)); const int lane = tid & 63, gw = (int)blockIdx.x * NWAVES + (tid >> 6), NGW = (int)gridDim.x * NWAVES;
      v4f gg[4];
#pragma unroll
      for (int j = 0; j < 4; ++j) gg[j] = *((const v4f*)(fg + 16 * lane) + j);
      for (int row0 = gw; row0 < MROWS; row0 += 4 * NGW) {
        v4u ra[4], rb[4];
#pragma unroll
        for (int k = 0; k < 4; ++k) { const int row = row0 + k * NGW < MROWS ? row0 + k * NGW : row0; const u16* xr = xb + tl(row, 16 * lane, DM); ra[k] = *(const v4u*)xr; rb[k] = *(const v4u*)(xr + 8); }
        asm volatile("" ::: "memory");
#pragma unroll
        for (int k = 0; k < 4; ++k) { const int row = row0 + k * NGW; if (row < MROWS) { float x[16]; float sq = 0.f;
            unpack8(ra[k], x); unpack8(rb[k], x + 8);
#pragma unroll
            for (int i = 0; i < 16; ++i) sq += x[i] * x[i];
            const float rs = rsqrtf(wave_sum(sq, lane) * (1.0f / DM) + EPS);
            v4f* op = (v4f*)(outp + (size_t)row * DM + 16 * lane);
#pragma unroll
            for (int j = 0; j < 4; ++j) op[j] = (v4f){x[4 * j] * rs * gg[j].x, x[4 * j + 1] * rs * gg[j].y, x[4 * j + 2] * rs * gg[j].z, x[4 * j + 3] * rs * gg[j].w}; } }
      } }
}

extern "C" void kernel_launch(void* const* d_in, const int* in_sizes, int n_in, void* d_out, int out_size, void* d_ws, size_t ws_size, hipStream_t stream) {
    static int grid = 0;
    if (grid == 0) {
        if (n_in != 23 || in_sizes[0] != MROWS * DM || out_size != MROWS * DM || ws_size < WS_END) { fprintf(stderr, "kernel_launch: unexpected shapes / workspace (n_in %d, ws %zu)\n", n_in, ws_size); grid = -1; return; }
        int dev = 0, cus = 0, per_cu = 0;
        hipGetDevice(&dev); hipDeviceGetAttribute(&cus, hipDeviceAttributeMultiprocessorCount, dev);
        hipFuncSetAttribute((const void*)trunk_fwd, hipFuncAttributeMaxDynamicSharedMemorySize, LDS_BYTES);
        hipOccupancyMaxActiveBlocksPerMultiprocessor(&per_cu, (const void*)trunk_fwd, NTHR, LDS_BYTES);
        (void)hipGetLastError();
        if (per_cu < 1) per_cu = 1;
        grid = cus * 1;
        if (grid <= 0) grid = 256;
    }
    if (grid < 0) return;
    Args a{};
    for (int i = 0; i < 23; ++i) a.in[i] = d_in[i];
    a.out = (float*)d_out; a.ws = (unsigned char*)d_ws;
    void* kargs[] = {&a};
    hipError_t e = hipLaunchCooperativeKernel((const void*)trunk_fwd, dim3(grid), dim3(NTHR), kargs, LDS_BYTES, stream);
    if (e != hipSuccess) fprintf(stderr, "cooperative launch failed: %s (grid %d)\n", hipGetErrorString(e), grid);
}
```

```cpp
#include <hip/hip_runtime.h>
#include <cstdio>
#include <cstdint>
namespace pg8 {
#define PG8_LAS __attribute__((address_space(3)))
typedef unsigned short bf16_t;
typedef short bf16x8 __attribute__((ext_vector_type(8)));
typedef float f32x4 __attribute__((ext_vector_type(4)));
typedef unsigned u32x4 __attribute__((ext_vector_type(4)));
constexpr int BM = 256, BK = 64, HALF = 128, HTB = HALF * BK * 2  , STAGE_BYTES = 8 * HTB, NXCD = 8, WGM = 8;

__host__ __device__ __forceinline__ int lds_byte(int r, int c) { const int st = (r >> 4) * 2 + (c >> 5), rr = r & 15, cc = c & 31, ob = rr * 64 + cc * 2; return st * 1024 + (ob ^ (((ob >> 9) & 1) << 5)); }
__host__ __device__ __forceinline__ void stage_rc(int b, int& R, int& C) { const int st = b / 1024, sb = b % 1024, swz = sb ^ (((sb >> 9) & 1) << 5); R = (st >> 1) * 16 + swz / 64; C = (st & 1) * 32 + (swz % 64) / 2; }
__host__ __device__ __forceinline__ int perm32(int rho) { const int n = rho >> 4, i = rho & 15; return 8 * (i >> 2) + 4 * n + (i & 3); }

struct Unit { int pm, pn; };
struct Gemm { const bf16_t* A; const bf16_t* Bt; int M, N, K; };

struct StaticOrder {
    int nM, nN, nwg, G, c;
    __host__ __device__ void init(int M, int N, int G_, int c_) { nM = M / BM; nN = N / BM; nwg = nM * nN; G = G_; c = c_; }
    __host__ __device__ bool next(int i, Unit& u) const {
        const long L = (long)i * G + c; if (L >= nwg) return false;
        int wgid = (int)L; { const int q = nwg / NXCD, r = nwg % NXCD, xcd = wgid % NXCD, off = wgid / NXCD; wgid = (xcd < r ? xcd * (q + 1) : r * (q + 1) + (xcd - r) * q) + off; }
        const int nig = WGM * nN, gid = wgid / nig, fm = gid * WGM, gsz = (nM - fm) < WGM ? (nM - fm) : WGM;
        u.pm = fm + ((wgid % nig) % gsz); u.pn = (wgid % nig) / gsz; return true;
    }
    __device__ __forceinline__ void a_ready(const Unit&) const {}
    __device__ __forceinline__ void done(const Unit&) const {}
};

__device__ __forceinline__ unsigned cvt_pk_bf16(float lo, float hi) { unsigned r; asm volatile("v_cvt_pk_bf16_f32 %0, %1, %2" : "=v"(r) : "v"(lo), "v"(hi)); return r; }
typedef float f32x2 __attribute__((ext_vector_type(2)));
__device__ __forceinline__ f32x2 gelu_pk(f32x2 v) {
    const f32x2 av = __builtin_elementwise_abs(v), d = av * 0.2316418882f + 1.0f;
    f32x2 t; t.x = __builtin_amdgcn_rcpf(d.x); t.y = __builtin_amdgcn_rcpf(d.y);
    f32x2 q = t * 0.5307027145f + (-0.7265760135f); q = q * t + 0.7107068705f; q = q * t + (-0.142248368f); q = q * t + 0.127414796f; q = q * t;
    const f32x2 s = (v * v) * (-0.72134752044f);
    f32x2 e; e.x = __builtin_amdgcn_exp2f(s.x); e.y = __builtin_amdgcn_exp2f(s.y);
    const f32x2 m = v * (q * e), r = v - m;
    f32x2 o; o.x = v.x < 0.f ? m.x : r.x; o.y = v.y < 0.f ? m.y : r.y; return o;
}

template <int ACT  > struct EpiBf16 {
    static constexpr bool PERM = true, AFTER_DRAIN = false; static_assert(ACT == 0 || ACT == 1, "EpiBf16: ACT is 0 (none) or 1 (gelu_pk)");
    bf16_t* O; int ldc; const float* bias; int split_cols; size_t split_stride; float scale0;
    __device__ __forceinline__ void operator()(const f32x4 (&acc)[2][2][4][2], const Unit& u, int wr, int wc, int fr, int fq) const {
        const int row0 = u.pm * BM + wr * 64 + fr; int colt = u.pn * BM; bf16_t* base = O;
        float sc = 1.f; if (split_cols) { const int t = colt / split_cols; base += (size_t)t * split_stride; colt -= t * split_cols; if (t == 0) sc = scale0; }
        const int col0 = colt + wc * 32 + 8 * fq, bcol0 = u.pn * BM + wc * 32 + 8 * fq;
        f32x4 bv[2][2];
#pragma unroll
        for (int bj = 0; bj < 2; ++bj)
#pragma unroll
            for (int n = 0; n < 2; ++n) bv[bj][n] = bias ? *(const f32x4*)(bias + bcol0 + bj * HALF + 4 * n) : (f32x4){0.f, 0.f, 0.f, 0.f};
#pragma unroll
        for (int ai = 0; ai < 2; ++ai)
#pragma unroll
            for (int m = 0; m < 4; ++m) { bf16_t* rowp = base + (size_t)(row0 + ai * HALF + m * 16) * ldc + col0;
#pragma unroll
                for (int bj = 0; bj < 2; ++bj) { f32x4 v0 = acc[ai][bj][m][0] + bv[bj][0], v1 = acc[ai][bj][m][1] + bv[bj][1];
                    if (ACT == 1) { f32x2 a = gelu_pk((f32x2){v0[0], v0[1]}), b = gelu_pk((f32x2){v0[2], v0[3]}), c = gelu_pk((f32x2){v1[0], v1[1]}), d = gelu_pk((f32x2){v1[2], v1[3]});
                        v0 = (f32x4){a.x, a.y, b.x, b.y}; v1 = (f32x4){c.x, c.y, d.x, d.y}; }
                    v0 = v0 * sc; v1 = v1 * sc; u32x4 w; w.x = cvt_pk_bf16(v0[0], v0[1]); w.y = cvt_pk_bf16(v0[2], v0[3]); w.z = cvt_pk_bf16(v1[0], v1[1]); w.w = cvt_pk_bf16(v1[2], v1[3]);
                    *(u32x4*)(rowp + bj * HALF) = w; } }
    }
};

template <class Epi, class Sched, bool ALIGN_EPI = false, bool SP2 = false>
__device__ __forceinline__ void gemm_phase(PG8_LAS unsigned char* lds, const Gemm g, const Sched& S, const Epi& E) {
    int tid = threadIdx.x; asm volatile("" : "+v"(tid));
    const int wid = __builtin_amdgcn_readfirstlane(tid >> 6), lane = tid & 63, wr = wid >> 2, wc = wid & 3, fr = lane & 15, fq = lane >> 4;
    const int K = g.K, nt = K / BK;
    unsigned voffA[2], voffB[2];
#pragma unroll
    for (int i = 0; i < 2; ++i) { int R, C; stage_rc(tid * 16 + i * 8192, R, C); const int Rb = Epi::PERM ? ((R & ~31) + perm32(R & 31)) : R;
        voffA[i] = (unsigned)(R * BK + C) * 2u; voffB[i] = (unsigned)(Rb * BK + C) * 2u; }
    const size_t kstep = (size_t)(BM * BK * 2);
    const size_t hstep = (size_t)HALF * BK * 2;
    const size_t tstep = (size_t)BM * K * 2;
    const unsigned ldsw = (unsigned)wid * 1024u;
    const int aoff = lds_byte(wr * 64 + fr, fq * 8), boff = lds_byte(wc * 32 + fr, fq * 8);
#define PG8_SA(b, h) (((b) * 2 + (h)) * HTB)
#define PG8_SB(b, h) ((4 + (b) * 2 + (h)) * HTB)
#define PG8_STAGE(bufoff, gbase, voff) do { _Pragma("unroll") for (int _i = 0; _i < 2; ++_i) \
        __builtin_amdgcn_global_load_lds((const unsigned*)((const char*)(gbase) + (voff)[_i]), (PG8_LAS unsigned*)(lds + (bufoff) + ldsw + _i * 8192), 16, 0, 0); } while (0)
#define PG8_LDA(dst, b, h) do { _Pragma("unroll") for (int m = 0; m < 4; ++m) _Pragma("unroll") for (int k = 0; k < 2; ++k) dst[m][k] = *(const PG8_LAS bf16x8*)(lds + PG8_SA(b, h) + aoff + m * 2048 + k * 1024); } while (0)
#define PG8_LDB(dst, b, h) do { _Pragma("unroll") for (int n = 0; n < 2; ++n) _Pragma("unroll") for (int k = 0; k < 2; ++k) dst[n][k] = *(const PG8_LAS bf16x8*)(lds + PG8_SB(b, h) + boff + n * 2048 + k * 1024); } while (0)
#define PG8_MMA(ai, bj, At, Bt) do { __builtin_amdgcn_s_setprio(1); _Pragma("unroll") for (int m = 0; m < 4; ++m) _Pragma("unroll") for (int n = 0; n < 2; ++n) _Pragma("unroll") for (int k = 0; k < 2; ++k) \
        acc[ai][bj][m][n] = __builtin_amdgcn_mfma_f32_16x16x32_bf16(Bt[n][k], At[m][k], acc[ai][bj][m][n], 0, 0, 0); __builtin_amdgcn_s_setprio(0); } while (0)
#define PG8_WAIT_V(n) asm volatile("s_waitcnt vmcnt(" #n ")" ::: "memory")
#define PG8_WAIT_L(n) asm volatile("s_waitcnt lgkmcnt(" #n ")" ::: "memory")
#define PG8_BAR __builtin_amdgcn_s_barrier()
#define PG8_SCHED __builtin_amdgcn_sched_barrier(0)
    Unit cur, nxt; int ui = 0;
    if (!S.next(0, cur)) return;
    f32x4 acc[2][2][4][2];
#pragma unroll
    for (int a = 0; a < 2; ++a)
#pragma unroll
        for (int b = 0; b < 2; ++b)
#pragma unroll
            for (int m = 0; m < 4; ++m)
#pragma unroll
                for (int n = 0; n < 2; ++n) acc[a][b][m][n] = (f32x4){0.f, 0.f, 0.f, 0.f};
    bf16x8 At[4][2], B0[2][2], B1[2][2];
    const char* cA = (const char*)g.A + (size_t)cur.pm * tstep; const char* cB = (const char*)g.Bt + (size_t)cur.pn * tstep;
    S.a_ready(cur);
    if constexpr (SP2) {
        PG8_STAGE(PG8_SB(0, 0), cB, voffB); PG8_STAGE(PG8_SB(0, 1), cB + hstep, voffB); PG8_STAGE(PG8_SA(0, 0), cA, voffA); PG8_STAGE(PG8_SA(0, 1), cA + hstep, voffA);
        if (wr == 1) PG8_BAR;
        PG8_WAIT_V(2); PG8_BAR;
        PG8_STAGE(PG8_SB(1, 0), cB + kstep, voffB); PG8_STAGE(PG8_SA(1, 0), cA + kstep, voffA); PG8_STAGE(PG8_SB(1, 1), cB + hstep + kstep, voffB);
        PG8_WAIT_V(6); PG8_BAR;
    } else {
        PG8_STAGE(PG8_SB(0, 0), cB, voffB); PG8_STAGE(PG8_SA(0, 0), cA, voffA); PG8_STAGE(PG8_SB(0, 1), cB + hstep, voffB); PG8_STAGE(PG8_SA(0, 1), cA + hstep, voffA);
        if (wr == 1) PG8_BAR;
        PG8_WAIT_V(4); PG8_BAR;
        PG8_STAGE(PG8_SB(1, 0), cB + kstep, voffB); PG8_STAGE(PG8_SA(1, 0), cA + kstep, voffA); PG8_STAGE(PG8_SB(1, 1), cB + hstep + kstep, voffB);
        PG8_WAIT_V(6); PG8_BAR;
    }
    for (;;) {
        const bool has_next = S.next(ui + 1, nxt);
        const char* nA = has_next ? (const char*)g.A + (size_t)nxt.pm * tstep : cA; const char* nB = has_next ? (const char*)g.Bt + (size_t)nxt.pn * tstep : cB;
        for (int t = 0; t < nt; t += 2) {
            const bool last = (t == nt - 2);
            const char* a1 = cA + (size_t)(t + 1) * kstep;
            const char* a2 = last ? nA : cA + (size_t)(t + 2) * kstep; const char* b2 = last ? nB : cB + (size_t)(t + 2) * kstep;
            const char* a3 = a2 + kstep; const char* b3 = b2 + kstep;
            if (last && has_next) S.a_ready(nxt);
            if constexpr (SP2) {
            PG8_LDB(B0, 0, 0); PG8_LDB(B1, 0, 1); PG8_SCHED; PG8_LDA(At, 0, 0); PG8_STAGE(PG8_SA(1, 1), a1 + hstep, voffA);
            PG8_WAIT_V(8); PG8_WAIT_L(0); PG8_BAR; PG8_MMA(0, 0, At, B0); PG8_MMA(0, 1, At, B1); PG8_BAR; PG8_SCHED;
            PG8_LDA(At, 0, 1); PG8_STAGE(PG8_SB(0, 0), b2, voffB); PG8_STAGE(PG8_SB(0, 1), b2 + hstep, voffB); PG8_STAGE(PG8_SA(0, 0), a2, voffA);
            PG8_WAIT_V(8); PG8_WAIT_L(0); PG8_BAR; PG8_MMA(1, 0, At, B0); PG8_MMA(1, 1, At, B1); PG8_BAR; PG8_SCHED;
            PG8_LDB(B0, 1, 0); PG8_LDB(B1, 1, 1); PG8_SCHED; PG8_LDA(At, 1, 0); PG8_STAGE(PG8_SA(0, 1), a2 + hstep, voffA);
            PG8_WAIT_V(8); PG8_WAIT_L(0); PG8_BAR; PG8_MMA(0, 0, At, B0); PG8_MMA(0, 1, At, B1); PG8_BAR; PG8_SCHED;
            PG8_LDA(At, 1, 1); PG8_STAGE(PG8_SB(1, 0), b3, voffB); PG8_STAGE(PG8_SB(1, 1), b3 + hstep, voffB); PG8_STAGE(PG8_SA(1, 0), a3, voffA);
            PG8_WAIT_V(8); PG8_WAIT_L(0); PG8_BAR; PG8_MMA(1, 0, At, B0); PG8_MMA(1, 1, At, B1); PG8_BAR; PG8_SCHED;
            } else {
            PG8_LDB(B0, 0, 0); PG8_SCHED; PG8_LDA(At, 0, 0); PG8_STAGE(PG8_SA(1, 1), a1 + hstep, voffA);
            PG8_WAIT_L(8); PG8_BAR; PG8_WAIT_L(0); PG8_MMA(0, 0, At, B0); PG8_BAR; PG8_SCHED;
            PG8_LDB(B1, 0, 1); PG8_STAGE(PG8_SB(0, 0), b2, voffB);
            PG8_BAR; PG8_WAIT_L(0); PG8_MMA(0, 1, At, B1); PG8_BAR;
            PG8_LDA(At, 0, 1); PG8_STAGE(PG8_SA(0, 0), a2, voffA);
            PG8_BAR; PG8_WAIT_L(0); PG8_MMA(1, 0, At, B0); PG8_BAR; PG8_SCHED;
            PG8_STAGE(PG8_SB(0, 1), b2 + hstep, voffB);
            PG8_WAIT_V(6); PG8_BAR; PG8_MMA(1, 1, At, B1); PG8_BAR;
            PG8_LDB(B0, 1, 0); PG8_SCHED; PG8_LDA(At, 1, 0); PG8_STAGE(PG8_SA(0, 1), a2 + hstep, voffA);
            PG8_WAIT_L(8); PG8_BAR; PG8_WAIT_L(0); PG8_MMA(0, 0, At, B0); PG8_BAR; PG8_SCHED;
            PG8_LDB(B1, 1, 1); PG8_STAGE(PG8_SB(1, 0), b3, voffB);
            PG8_BAR; PG8_WAIT_L(0); PG8_MMA(0, 1, At, B1); PG8_BAR;
            PG8_LDA(At, 1, 1); PG8_STAGE(PG8_SA(1, 0), a3, voffA);
            PG8_BAR; PG8_WAIT_L(0); PG8_MMA(1, 0, At, B0); PG8_BAR; PG8_SCHED;
            PG8_STAGE(PG8_SB(1, 1), b3 + hstep, voffB);
            PG8_WAIT_V(6); PG8_BAR; PG8_MMA(1, 1, At, B1); PG8_BAR;
            }
        }
        if constexpr (ALIGN_EPI) { if (wr == 0) PG8_BAR; }
        const bool keep = Epi::keep_acc(cur);
        if constexpr (!Epi::AFTER_DRAIN) { if (!keep) E(acc, cur, wr, wc, fr, fq); S.done(cur); }
        if (!has_next) break;
        if (!keep)
#pragma unroll
        for (int a = 0; a < 2; ++a)
#pragma unroll
            for (int b = 0; b < 2; ++b)
#pragma unroll
                for (int m = 0; m < 4; ++m)
#pragma unroll
                    for (int n = 0; n < 2; ++n) acc[a][b][m][n] = (f32x4){0.f, 0.f, 0.f, 0.f};
        cur = nxt; cA = nA; cB = nB; ++ui;
        if constexpr (ALIGN_EPI) { if (wr == 1) PG8_BAR; }
    }
    PG8_WAIT_V(0);
    if constexpr (!ALIGN_EPI) { if (wr == 0) PG8_BAR; }
    PG8_BAR;
    if constexpr (Epi::AFTER_DRAIN) { E.fused(acc, cur, wr, wc, fr, fq, lds, wid, lane); S.done(cur); }
#undef PG8_SA
#undef PG8_SB
#undef PG8_STAGE
#undef PG8_LDA
#undef PG8_LDB
#undef PG8_MMA
#undef PG8_WAIT_V
#undef PG8_WAIT_L
#undef PG8_BAR
#undef PG8_SCHED
}
}

#ifndef PG8_SP2
#define PG8_SP2 true
#endif
#ifndef PG8_ALIGN
#define PG8_ALIGN true
#endif
#include <hip/hip_bf16.h>
#include <cmath>
namespace attn_body {
using bf16=__hip_bfloat16;
using bf16x8=__attribute__((ext_vector_type(8)))short;
using s16x4=__attribute__((ext_vector_type(4)))short;
using f32x16=__attribute__((ext_vector_type(16)))float;
using u32x4=__attribute__((ext_vector_type(4)))unsigned;
constexpr int SEQ=4096,D=64,PZ=64,PO=1024;
constexpr int NW=8,QBLK=32,QB=QBLK*NW,KVBLK=64,NQB=SEQ/QB;
constexpr int ATTN_UNIT_ROWS=QB;
__device__ __forceinline__ int crow(int r,int hi){return (r&3)+8*(r>>2)+4*hi;}
#define SBAR() __builtin_amdgcn_sched_barrier(0)
__device__ __forceinline__ void cmask(f32x16&p0,f32x16&p1,int jb,int qrel,int hi){
  const float NEG=-INFINITY; int kb=64*jb+4*hi;
  #pragma unroll
  for(int r=0;r<16;++r){int kv=kb+(r&3)+8*(r>>2); if(kv>qrel)p0[r]=NEG; if(kv+32>qrel)p1[r]=NEG;}
}

constexpr int NSLOT=3, SLOTB=8192;
constexpr int LDS_K=0, LDS_V=NSLOT*SLOTB, LDS_V2=2*NSLOT*SLOTB  , LDS_WS=3*NSLOT*SLOTB, LDS_OST=LDS_WS+NW*64*4, LDS_BYTES=LDS_OST+NW*4096;
constexpr float C2=0.125f*1.4426950408889634f;
__device__ __forceinline__ void glds16(const void*gsrc,unsigned lds_dst){unsigned keep;
  asm volatile("s_mov_b32 %0, m0\n\ts_mov_b32 m0, %2\n\ts_nop 0\n\tglobal_load_lds_dwordx4 %1, off\n\ts_mov_b32 m0, %0":"=&s"(keep):"v"(gsrc),"s"(lds_dst):"memory");}
__device__ __forceinline__ float max3f(float a,float b,float c){float r;asm("v_max3_f32 %0, %1, %2, %3":"=v"(r):"v"(a),"v"(b),"v"(c));return r;}
__device__ __forceinline__ float max2f(float a,float b){float r;asm("v_max_f32_e32 %0, %1, %2":"=v"(r):"v"(a),"v"(b));return r;}
__device__ __forceinline__ float fadd_s(float a,float b){float r;asm("v_add_f32_e32 %0, %1, %2":"=v"(r):"v"(a),"v"(b));return r;}
__device__ __forceinline__ float fsub_s(float a,float b){float r;asm("v_sub_f32_e32 %0, %1, %2":"=v"(r):"v"(a),"v"(b));return r;}
typedef float f32x2_t __attribute__((ext_vector_type(2))); typedef __bf16 bf16x2_t __attribute__((ext_vector_type(2)));
__device__ __forceinline__ unsigned cvtpk_s(float lo,float hi){f32x2_t v={lo,hi};bf16x2_t b=__builtin_convertvector(v,bf16x2_t);return __builtin_bit_cast(unsigned,b);}
#define WAIT_BAR(N) asm volatile("s_waitcnt vmcnt(" #N ") lgkmcnt(0)\n\ts_barrier":::"memory")

__device__ __forceinline__ void qkt(f32x16&p0,f32x16&p1,const char*Kslot,const bf16x8*qr,const f32x16&negm,int r32,int hi){
  const char*kb=Kslot+hi*1024+r32*16;
  #pragma unroll
  for(int d0=0;d0<4;++d0){
    const bf16x8 b0=*reinterpret_cast<const bf16x8*>(kb+d0*2048);
    const bf16x8 b1=*reinterpret_cast<const bf16x8*>(kb+d0*2048+512);
    if(d0==0){p0=__builtin_amdgcn_mfma_f32_32x32x16_bf16(b0,qr[0],negm,0,0,0);p1=__builtin_amdgcn_mfma_f32_32x32x16_bf16(b1,qr[0],negm,0,0,0);}
    else{p0=__builtin_amdgcn_mfma_f32_32x32x16_bf16(b0,qr[d0],p0,0,0,0);p1=__builtin_amdgcn_mfma_f32_32x32x16_bf16(b1,qr[d0],p1,0,0,0);}}
}
typedef __attribute__((address_space(3))) const char* lds_cptr;
typedef short v4i16_t __attribute__((ext_vector_type(4)));
__device__ __forceinline__ void kload8(bf16x8*kf,lds_cptr kp){
  kf[0]=*(const __attribute__((address_space(3))) bf16x8*)(kp);      kf[1]=*(const __attribute__((address_space(3))) bf16x8*)(kp+512);
  kf[2]=*(const __attribute__((address_space(3))) bf16x8*)(kp+2048); kf[3]=*(const __attribute__((address_space(3))) bf16x8*)(kp+2560);
  kf[4]=*(const __attribute__((address_space(3))) bf16x8*)(kp+4096); kf[5]=*(const __attribute__((address_space(3))) bf16x8*)(kp+4608);
  kf[6]=*(const __attribute__((address_space(3))) bf16x8*)(kp+6144); kf[7]=*(const __attribute__((address_space(3))) bf16x8*)(kp+6656);
}
__device__ __forceinline__ void kload2(bf16x8*kf,lds_cptr kp,int j){ kf[2*j]=*(const __attribute__((address_space(3))) bf16x8*)(kp+j*2048); kf[2*j+1]=*(const __attribute__((address_space(3))) bf16x8*)(kp+j*2048+512); }
__device__ __forceinline__ s16x4 vtr(lds_cptr p){ return __builtin_bit_cast(s16x4,__builtin_amdgcn_ds_read_tr16_b64_v4i16((__attribute__((address_space(3))) v4i16_t*)p)); }
__device__ __forceinline__ float rowmax(const f32x16&p0,const f32x16&p1){
  float a=max3f(p0[0],p0[1],p1[0]),b=max3f(p0[2],p0[3],p1[1]);a=max3f(a,p1[2],p1[3]);
  #pragma unroll
  for(int r=4;r<16;r+=4){a=max3f(a,p0[r],p0[r+1]);b=max3f(b,p0[r+2],p0[r+3]);a=max3f(a,p1[r],p1[r+1]);b=max3f(b,p1[r+2],p1[r+3]);}
  const float m=max2f(a,b);
  auto rr=__builtin_amdgcn_permlane32_swap(__float_as_uint(m),__float_as_uint(m),false,false);
  return max2f(__uint_as_float(rr[0]),__uint_as_float(rr[1]));
}
__device__ __forceinline__ void pv(f32x16*o,int vb,bf16x8 pa0,bf16x8 pa1,bf16x8 pa2,bf16x8 pa3){
  #pragma unroll
  for(int d0=0;d0<2;++d0){s16x4 lo[4],hi[4];
    #pragma unroll
    for(int ks=0;ks<4;++ks){
      asm volatile("ds_read_b64_tr_b16 %0,%1 offset:%c2":"=&v"(lo[ks]):"v"(vb),"i"(d0*4096+ks*1024):"memory");
      asm volatile("ds_read_b64_tr_b16 %0,%1 offset:%c2":"=&v"(hi[ks]):"v"(vb),"i"(d0*4096+ks*1024+512):"memory");}
    asm volatile("s_waitcnt lgkmcnt(0)":::"memory");SBAR();
    #define PK(k) (bf16x8){lo[k][0],lo[k][1],lo[k][2],lo[k][3],hi[k][0],hi[k][1],hi[k][2],hi[k][3]}
    o[d0]=__builtin_amdgcn_mfma_f32_32x32x16_bf16(pa0,PK(0),o[d0],0,0,0);
    o[d0]=__builtin_amdgcn_mfma_f32_32x32x16_bf16(pa1,PK(1),o[d0],0,0,0);
    o[d0]=__builtin_amdgcn_mfma_f32_32x32x16_bf16(pa2,PK(2),o[d0],0,0,0);
    o[d0]=__builtin_amdgcn_mfma_f32_32x32x16_bf16(pa3,PK(3),o[d0],0,0,0);
    #undef PK
  }
}

#ifndef ATTN_STORE16
#define ATTN_STORE16(p,v) (*(u32x4*)(p)=(v))
#endif
template<int THRL> __device__ __forceinline__ void attn_unit(int qb,const bf16*Q,const bf16*__restrict__ K,const bf16*__restrict__ V,bf16*O,char*shm){
  int tid=threadIdx.x; asm volatile("":"+v"(tid)); const int lane=tid&63,r32=lane&31,hi=lane>>5; const int wid=__builtin_amdgcn_readfirstlane(tid>>6);
  const int q0=qb*QB;
  const bf16*Qw=Q+(long)(q0+wid*QBLK)*PZ;
  const bf16*Kh=K,*Vh=V;
  const unsigned lds0=(unsigned)(uintptr_t)shm;
  float*wsf=(float*)(shm+LDS_WS)+wid*64;
  const bf16*ksrc=Kh+(long)lane*PZ+wid*8;
  const bf16*vsrc=Vh+(long)(16*(wid&3)+(lane>>2))*PZ+(wid>>2)*32+(lane&3)*8;
  const unsigned kdst=lds0+LDS_K+wid*1024, vdst=lds0+LDS_V+wid*1024;
  #define DMA_K(t,slot) glds16(ksrc+(long)(t)*KVBLK*PZ,(unsigned)__builtin_amdgcn_readfirstlane(kdst+(slot)))
  #define DMA_V(t,slot) do{ glds16(vsrc+(long)(t)*KVBLK*PZ,(unsigned)__builtin_amdgcn_readfirstlane(vdst+(slot))); glds16(vsrc+(long)SEQ*PZ+(long)(t)*KVBLK*PZ,(unsigned)__builtin_amdgcn_readfirstlane(vdst+NSLOT*SLOTB+(slot))); }while(0)
  const int vb0=(int)(lds0+LDS_V)+((lane>>4)&1)*32+(lane&3)*8+(4*hi+((lane&15)>>2))*64;
  const char*Kbase=shm+LDS_K; bf16x8 kf[8];
  const lds_cptr shm3=(lds_cptr)shm; const lds_cptr kp0=shm3+LDS_K+hi*1024+r32*16; const lds_cptr vp0=shm3+LDS_V+((lane>>4)&1)*32+(lane&3)*8+(4*hi+((lane&15)>>2))*64;
  const int NT=(q0+QB)/KVBLK;
  DMA_K(0,0);DMA_V(0,0);DMA_K(1,SLOTB);
  bf16x8 qr[4];
  #pragma unroll
  for(int d0=0;d0<4;++d0)qr[d0]=*reinterpret_cast<const bf16x8*>(&Qw[(long)r32*PZ+d0*16+hi*8]);
  float mhat=0.f,l_reg=0.f;f32x16 o[4];o[0]=f32x16{};o[1]=f32x16{};o[2]=f32x16{};o[3]=f32x16{};f32x16 negm=f32x16{};asm volatile("":"+v"(negm));
  const int qrel=wid*QBLK+r32;
  #define CMASK(P0,P1,t) do{int jb_=(t)-(NT-4); if(jb_>=0)cmask(P0,P1,jb_,qrel,hi);}while(0)
  bool resc=false;
  #define START(P0,P1) do{ const float rm=rowmax(P0,P1); resc=false; \
    { const float dl=rm; mhat=fadd_s(mhat,dl); \
      _Pragma("unroll") for(int r=0;r<16;++r){P0[r]=fsub_s(P0[r],dl);P1[r]=fsub_s(P1[r],dl);} \
      _Pragma("unroll") for(int r=0;r<16;++r)negm[r]=-mhat; asm volatile("":"+v"(negm)); } \
    _Pragma("unroll") for(int r=0;r<16;++r)P0[r]=__builtin_amdgcn_exp2f(P0[r]); }while(0)
  #define RESC() do{ if(resc){ asm volatile("s_waitcnt lgkmcnt(0)":::"memory"); \
      _Pragma("unroll") for(int d_=0;d_<4;++d_) _Pragma("unroll") for(int r=0;r<16;++r)o[d_][r]*=wsf[crow(r,hi)]; } }while(0)
  f32x16 pA0,pA1,pB0,pB1;
  int sl_prev=0,sl_cur=0,sl_next=SLOTB;
  #define ROT() do{sl_prev=sl_cur;sl_cur=sl_next;sl_next=(sl_next==(NSLOT-1)*SLOTB)?0:sl_next+SLOTB;}while(0)
  DMA_K(2,2*SLOTB);
  WAIT_BAR(4);
  qkt(pA0,pA1,Kbase,qr,negm,r32,hi);asm volatile("s_nop 15\n\ts_nop 7":"+v"(pA0),"+v"(pA1));CMASK(pA0,pA1,0);
  START(pA0,pA1);
  _Pragma("unroll") for(int r=0;r<16;++r)pA1[r]=__builtin_amdgcn_exp2f(pA1[r]);
  WAIT_BAR(0);
  DMA_K(3,0);DMA_V(1,SLOTB);
  ROT();
  kload8(kf,kp0+sl_cur);
  WAIT_BAR(3);
  s16x4 vlo[8],vhi[8]; u32x4 pw0,pw1,pw2,pw3;
  #define PKW(P,B) cvtpk_s(P[B],P[B+1])
  #define PAF(k) __builtin_bit_cast(bf16x8,pw##k)
  #define VFR(i) (bf16x8){vlo[i][0],vlo[i][1],vlo[i][2],vlo[i][3],vhi[i][0],vhi[i][1],vhi[i][2],vhi[i][3]}
  #define PIN(x) asm volatile("":"+v"(x))
  #define MX3(a,b,c) __builtin_fmaxf(__builtin_fmaxf((a),(b)),(c))
  #define GAPA(MF,A0,A1,A2,A3,W0,W1,PW) do{ MF; sacc+=A0; sacc+=A1; sacc+=A2; sacc+=A3; PIN(sacc); W0; W1; PIN(PW); SBAR(); }while(0)
  #define EX(v) __builtin_amdgcn_exp2f(v)
  #define GAPB(MF,X,B) do{ MF; X[B]=EX(X[B]); X[B+1]=EX(X[B+1]); X[B+2]=EX(X[B+2]); X[B+3]=EX(X[B+3]); PIN(X); SBAR(); }while(0)
  #define GAPE(MF,X,B) do{ MF; X[B]=EX(X[B]); X[B+1]=EX(X[B+1]); PIN(X); SBAR(); }while(0)
  #define VRD(i) do{ vlo[i]=vtr(vp_+(((i)>>2)*4096+((i)&3)*1024)); vhi[i]=vtr(vp_+(((i)>>2)*4096+((i)&3)*1024+512)); }while(0)
  #define VRD2(i) do{ vlo[i]=vtr(vp_+(NSLOT*SLOTB+((i)>>2)*4096+((i)&3)*1024)); vhi[i]=vtr(vp_+(NSLOT*SLOTB+((i)>>2)*4096+((i)&3)*1024+512)); SBAR(); }while(0)
  #define KRD(G,j) do{ if(G){ kload2(kf,kp0+sl_next,j); SBAR(); } }while(0)
  #define STEP(C0,C1,P0,P1,t,GK,GV,GL) do{ SBAR(); \
    const lds_cptr vp_=vp0+sl_prev; \
    VRD(0); SBAR(); float sacc=(P0[0]+P0[1]); \
    GAPA(C0=__builtin_amdgcn_mfma_f32_32x32x16_bf16(kf[0],qr[0],negm,0,0,0), P0[2],P0[3],P0[4],P0[5],     pw0[0]=PKW(P0,0), pw0[1]=PKW(P0,2), pw0); \
    VRD(4); SBAR(); GAPA(C1=__builtin_amdgcn_mfma_f32_32x32x16_bf16(kf[1],qr[0],negm,0,0,0), P0[6],P0[7],P0[8],P0[9],     pw0[2]=PKW(P0,4), pw0[3]=PKW(P0,6), pw0); \
    VRD(1); SBAR(); GAPA(C0=__builtin_amdgcn_mfma_f32_32x32x16_bf16(kf[2],qr[1],C0,0,0,0),   P0[10],P0[11],P0[12],P0[13], pw1[0]=PKW(P0,8), pw1[1]=PKW(P0,10), pw1); \
    VRD(5); SBAR(); GAPA(C1=__builtin_amdgcn_mfma_f32_32x32x16_bf16(kf[3],qr[1],C1,0,0,0),   P0[14],P0[15],P1[0],P1[1],   pw1[2]=PKW(P0,12),pw1[3]=PKW(P0,14), pw1); \
    VRD(2); SBAR(); GAPA(C0=__builtin_amdgcn_mfma_f32_32x32x16_bf16(kf[4],qr[2],C0,0,0,0),   P1[2],P1[3],P1[4],P1[5],     pw2[0]=PKW(P1,0), pw2[1]=PKW(P1,2), pw2); \
    VRD(6); SBAR(); GAPA(C1=__builtin_amdgcn_mfma_f32_32x32x16_bf16(kf[5],qr[2],C1,0,0,0),   P1[6],P1[7],P1[8],P1[9],     pw2[2]=PKW(P1,4), pw2[3]=PKW(P1,6), pw2); \
    VRD(3); SBAR(); GAPA(C0=__builtin_amdgcn_mfma_f32_32x32x16_bf16(kf[6],qr[3],C0,0,0,0),   P1[10],P1[11],P1[12],P1[13], pw3[0]=PKW(P1,8), pw3[1]=PKW(P1,10), pw3); \
    VRD(7); SBAR(); GAPA(C1=__builtin_amdgcn_mfma_f32_32x32x16_bf16(kf[7],qr[3],C1,0,0,0),   P1[14],P1[15],0.f,0.f,       pw3[2]=PKW(P1,12),pw3[3]=PKW(P1,14), pw3); \
    l_reg+=sacc; \
    if(GK){DMA_K((t)+3,sl_cur);} if(GV){DMA_V((t)+1,sl_next);} \
    CMASK(C0,C1,t); \
    { float a=MX3(C0[0],C0[1],C1[0]),b=MX3(C0[2],C0[3],C1[1]); a=MX3(a,C1[2],C1[3]); \
      _Pragma("unroll") for(int r=4;r<16;r+=4){a=MX3(a,C0[r],C0[r+1]);b=MX3(b,C0[r+2],C0[r+3]);a=MX3(a,C1[r],C1[r+1]);b=MX3(b,C1[r+2],C1[r+3]);} \
      float rm=__builtin_fmaxf(a,b); { auto rr=__builtin_amdgcn_permlane32_swap(__float_as_uint(rm),__float_as_uint(rm),false,false); rm=__builtin_fmaxf(__uint_as_float(rr[0]),__uint_as_float(rr[1])); } \
      resc=false; \
      if(__builtin_expect(__any(rm>(float)THRL),0)){ const float dl=__builtin_fmaxf(rm,0.f); mhat+=dl; \
        _Pragma("unroll") for(int r=0;r<16;++r){C0[r]-=dl;C1[r]-=dl;} \
        _Pragma("unroll") for(int r=0;r<16;++r)negm[r]=-mhat; asm volatile("":"+v"(negm)); \
        const float f=__builtin_amdgcn_exp2f(-dl); l_reg*=f; if(hi==0)wsf[r32]=f; resc=true; } } \
    SBAR(); \
    GAPE(o[0]=__builtin_amdgcn_mfma_f32_32x32x16_bf16(PAF(0),VFR(0),o[0],0,0,0), C0,0); VRD2(0); \
    GAPE(o[1]=__builtin_amdgcn_mfma_f32_32x32x16_bf16(PAF(0),VFR(4),o[1],0,0,0), C0,2); VRD2(4); \
    KRD(GL,0); GAPE(o[0]=__builtin_amdgcn_mfma_f32_32x32x16_bf16(PAF(1),VFR(1),o[0],0,0,0), C0,4); VRD2(1); \
    KRD(GL,1); GAPE(o[1]=__builtin_amdgcn_mfma_f32_32x32x16_bf16(PAF(1),VFR(5),o[1],0,0,0), C0,6); VRD2(5); \
    KRD(GL,2); GAPE(o[0]=__builtin_amdgcn_mfma_f32_32x32x16_bf16(PAF(2),VFR(2),o[0],0,0,0), C0,8); VRD2(2); \
    KRD(GL,3); GAPE(o[1]=__builtin_amdgcn_mfma_f32_32x32x16_bf16(PAF(2),VFR(6),o[1],0,0,0), C0,10); VRD2(6); \
    GAPE(o[0]=__builtin_amdgcn_mfma_f32_32x32x16_bf16(PAF(3),VFR(3),o[0],0,0,0), C0,12); VRD2(3); \
    GAPE(o[1]=__builtin_amdgcn_mfma_f32_32x32x16_bf16(PAF(3),VFR(7),o[1],0,0,0), C0,14); VRD2(7); \
      \
    GAPE(o[2]=__builtin_amdgcn_mfma_f32_32x32x16_bf16(PAF(0),VFR(0),o[2],0,0,0), C1,0); \
    GAPE(o[3]=__builtin_amdgcn_mfma_f32_32x32x16_bf16(PAF(0),VFR(4),o[3],0,0,0), C1,2); \
    GAPE(o[2]=__builtin_amdgcn_mfma_f32_32x32x16_bf16(PAF(1),VFR(1),o[2],0,0,0), C1,4); \
    GAPE(o[3]=__builtin_amdgcn_mfma_f32_32x32x16_bf16(PAF(1),VFR(5),o[3],0,0,0), C1,6); \
    GAPE(o[2]=__builtin_amdgcn_mfma_f32_32x32x16_bf16(PAF(2),VFR(2),o[2],0,0,0), C1,8); \
    GAPE(o[3]=__builtin_amdgcn_mfma_f32_32x32x16_bf16(PAF(2),VFR(6),o[3],0,0,0), C1,10); \
    GAPE(o[2]=__builtin_amdgcn_mfma_f32_32x32x16_bf16(PAF(3),VFR(3),o[2],0,0,0), C1,12); \
    GAPE(o[3]=__builtin_amdgcn_mfma_f32_32x32x16_bf16(PAF(3),VFR(7),o[3],0,0,0), C1,14); \
    }while(0)
  int t=1;
  #undef CMASK
  #define CMASK(P0,P1,t) do{}while(0)
  for(;t+5<NT;t+=2){
    STEP(pB0,pB1,pA0,pA1,t,true,true,true);     WAIT_BAR(3); RESC(); ROT();
    STEP(pA0,pA1,pB0,pB1,t+1,true,true,true);   WAIT_BAR(3); RESC(); ROT();
  }
  #undef CMASK
  #define CMASK(P0,P1,t) do{int jb_=(t)-(NT-4); if(jb_>=0)cmask(P0,P1,jb_,qrel,hi);}while(0)
  #define ENDW(tt) do{ if((tt)+3<NT){WAIT_BAR(3);} else if((tt)+2<NT){WAIT_BAR(2);} else {WAIT_BAR(0);} }while(0)
  for(;t+1<NT;t+=2){
    STEP(pB0,pB1,pA0,pA1,t,(t+3<NT),(t+1<NT),(t+1<NT));       ENDW(t);   RESC(); ROT();
    STEP(pA0,pA1,pB0,pB1,t+1,(t+4<NT),(t+2<NT),(t+2<NT));     ENDW(t+1); RESC(); ROT();
  }
  STEP(pB0,pB1,pA0,pA1,NT-1,false,false,false); RESC();
  { float sacc=pB0[0]+pB0[1]; _Pragma("unroll") for(int r=2;r<16;++r)sacc+=pB0[r]; _Pragma("unroll") for(int r=0;r<16;++r)sacc+=pB1[r]; l_reg+=sacc;
    pw0=(u32x4){PKW(pB0,0),PKW(pB0,2),PKW(pB0,4),PKW(pB0,6)};pw1=(u32x4){PKW(pB0,8),PKW(pB0,10),PKW(pB0,12),PKW(pB0,14)};pw2=(u32x4){PKW(pB1,0),PKW(pB1,2),PKW(pB1,4),PKW(pB1,6)};pw3=(u32x4){PKW(pB1,8),PKW(pB1,10),PKW(pB1,12),PKW(pB1,14)};
    SBAR(); pv(o,vb0+sl_cur,PAF(0),PAF(1),PAF(2),PAF(3)); pv(o+2,vb0+NSLOT*SLOTB+sl_cur,PAF(0),PAF(1),PAF(2),PAF(3)); }
  #undef PKW
  #undef PAF
  #undef VFR
  #undef PIN
  #undef MX3
  #undef GAPA
  #undef GAPB
  #undef GAPE
  #undef EX
  #undef VRD
  #undef VRD2
  #undef KRD
  #undef STEP
  #undef ENDW
  {auto rr=__builtin_amdgcn_permlane32_swap(__float_as_uint(l_reg),__float_as_uint(l_reg),false,false);l_reg=__uint_as_float(rr[0])+__uint_as_float(rr[1]);}
  if(hi==0)wsf[32+r32]=l_reg;asm volatile("s_waitcnt lgkmcnt(0)":::"memory");
  float rli[16];
  #pragma unroll
  for(int r=0;r<16;++r)rli[r]=__builtin_amdgcn_rcpf(wsf[32+crow(r,hi)]);
  bf16*Ow=O+(long)(q0+wid*QBLK)*PO;
  { bf16*stg=(bf16*)(shm+LDS_OST)+wid*2048;
    #pragma unroll
    for(int hf=0;hf<2;++hf){
      #pragma unroll
      for(int r=0;r<16;++r){const int orow=crow(r,hi);
        #pragma unroll
        for(int d0=0;d0<2;++d0)stg[orow*64+d0*32+r32]=__float2bfloat16(o[2*hf+d0][r]*rli[r]);}
      asm volatile("s_waitcnt lgkmcnt(0)":::"memory");
      #pragma unroll
      for(int i=0;i<4;++i){const int row=i*8+(lane>>3),ch=lane&7; const u32x4 v=*(const u32x4*)(stg+row*64+ch*8); ATTN_STORE16(Ow+(long)row*PO+hf*64+ch*8,v);}
      asm volatile("s_waitcnt lgkmcnt(0)":::"memory"); } }
  asm volatile("s_waitcnt lgkmcnt(0)\n\ts_barrier":::"memory");
  #undef DMA_K
  #undef DMA_V
  #undef CMASK
  #undef START
  #undef RESC
  #undef ROT
}
constexpr int ATTN_LDS_BYTES=LDS_BYTES;
#undef SBAR
#undef WAIT_BAR
}

#include <hip/hip_cooperative_groups.h>
namespace cg = cooperative_groups;
#define LAS __attribute__((address_space(3)))
typedef unsigned short u16;
typedef unsigned v4u __attribute__((ext_vector_type(4)));
typedef unsigned v2u __attribute__((ext_vector_type(2)));
typedef float v4f __attribute__((ext_vector_type(4)));
typedef short v8s __attribute__((ext_vector_type(8)));

constexpr int NWAVES = 8, NTHR = 512;
constexpr int BATCH = 8, SEQ = 4096, DM = 1024, MROWS = BATCH * SEQ, MH = MROWS / 2, FF = 2816, NIN = 5896, ZP = 2816, ZPB = 2 * ZP, ZGATE_B = 5 * 512, NLAYER = 2;
constexpr float EPS = 1e-6f;
constexpr float QC2 = 0.125f * 1.4426950408889634f;
constexpr int LDS_BYTES = 147456;

constexpr size_t MiB = 1u << 20, KiB = 1u << 10;
constexpr size_t WS_BAR = 0, CTL_ZERO_BYTES = 64 * KiB;
constexpr size_t WS_W = 2 * MiB, W_LSTRIDE = 49 * MiB;
constexpr size_t WO_13A = 0, WO_2A = 11 * MiB, WO_IN = 16 * MiB + 512 * KiB, WO_PA = 28 * MiB + 512 * KiB, WO_PB = 29 * MiB, WO_PC = 29 * MiB + 512 * KiB,
                 WO_OUT = 30 * MiB + 512 * KiB, WO_13B = 32 * MiB + 512 * KiB, WO_2B = 43 * MiB + 512 * KiB;
constexpr size_t WS_XB = 100 * MiB, WS_ZA = 164 * MiB, WS_O = 340 * MiB, WS_QC = 372 * MiB, WS_KC = 388 * MiB, WS_VC = 404 * MiB, WS_MG = WS_QC  , WS_U = 420 * MiB, WS_CST = 436 * MiB,
                 WS_YA = 444 * MiB, WS_YB = 452 * MiB, WS_YC = 460 * MiB, WS_MIF = 476 * MiB, WS_COS = 477 * MiB, WS_SIN = 481 * MiB, WS_SSP = 485 * MiB,
                 WS_NU = 487 * MiB, WS_NST = 487 * MiB + 256 * KiB, WS_ML = 487 * MiB + 512 * KiB, WS_BL = WS_ML + 4 * KiB, WS_MST = WS_BL + 4 * KiB, WS_END = 488 * MiB;
static_assert((size_t)MH * ZP * 2 <= WS_O - WS_ZA && (size_t)MROWS * FF * 2 <= WS_O - WS_ZA, "z / act region");

__device__ __forceinline__ unsigned f2bf(float f) { unsigned u = __builtin_bit_cast(unsigned, f); return (u + 0x7fffu + ((u >> 16) & 1u)) >> 16; }
typedef float f32x2_ __attribute__((ext_vector_type(2))); typedef __bf16 bf16x2_ __attribute__((ext_vector_type(2)));
__device__ __forceinline__ unsigned pk2(float lo, float hi) { const f32x2_ v = {lo, hi}; const bf16x2_ b = __builtin_convertvector(v, bf16x2_); return __builtin_bit_cast(unsigned, b); }
__device__ __forceinline__ float bflo(unsigned w) { return __uint_as_float(w << 16); }
__device__ __forceinline__ float bfhi(unsigned w) { return __uint_as_float(w & 0xffff0000u); }
__device__ __forceinline__ void unpack8(const v4u r, float* x) { x[0] = bflo(r.x); x[1] = bfhi(r.x); x[2] = bflo(r.y); x[3] = bfhi(r.y); x[4] = bflo(r.z); x[5] = bfhi(r.z); x[6] = bflo(r.w); x[7] = bfhi(r.w); }
__device__ __forceinline__ v4u pack8(const float* x) { v4u o; o.x = pk2(x[0], x[1]); o.y = pk2(x[2], x[3]); o.z = pk2(x[4], x[5]); o.w = pk2(x[6], x[7]); return o; }
__device__ __forceinline__ float sigmoidf_(float x) { return __builtin_amdgcn_rcpf(1.0f + __builtin_amdgcn_exp2f(-1.4426950408889634f * x)); }
__device__ __forceinline__ float siluf_(float x) { return x * __builtin_amdgcn_rcpf(1.0f + __builtin_amdgcn_exp2f(-1.4426950408889634f * x)); }
__device__ __forceinline__ float shl_(float v, int src) { return __int_as_float(__builtin_amdgcn_ds_bpermute(src << 2, __float_as_int(v))); }
__device__ __forceinline__ float shx_(float v, int lane, int o) { return shl_(v, lane ^ o); }
template <int CTRL, int ROWMASK> __device__ __forceinline__ float dpp_(float oldv, float src) {
    return __int_as_float(__builtin_amdgcn_update_dpp(__float_as_int(oldv), __float_as_int(src), CTRL, ROWMASK, 0xF, false));
}
__device__ __forceinline__ float wave_incl_sum(float v, int) {
    v += dpp_<0x111, 0xF>(0.f, v); v += dpp_<0x112, 0xF>(0.f, v); v += dpp_<0x114, 0xF>(0.f, v); v += dpp_<0x118, 0xF>(0.f, v);
    v += dpp_<0x142, 0xA>(0.f, v); v += dpp_<0x143, 0xC>(0.f, v);
    return v;
}
__device__ __forceinline__ float wave_incl_max(float v, int) {
    const float ninf = -__builtin_inff();
    v = fmaxf(v, dpp_<0x111, 0xF>(ninf, v)); v = fmaxf(v, dpp_<0x112, 0xF>(ninf, v)); v = fmaxf(v, dpp_<0x114, 0xF>(ninf, v)); v = fmaxf(v, dpp_<0x118, 0xF>(ninf, v));
    v = fmaxf(v, dpp_<0x142, 0xA>(ninf, v)); v = fmaxf(v, dpp_<0x143, 0xC>(ninf, v));
    return v;
}
__device__ __forceinline__ float lane63_(float v) { return __int_as_float(__builtin_amdgcn_readlane(__float_as_int(v), 63)); }
__device__ __forceinline__ float wave_sum(float v, int lane) { return lane63_(wave_incl_sum(v, lane)); }
__device__ __forceinline__ float wave_max(float v, int lane) { return lane63_(wave_incl_max(v, lane)); }
__device__ __forceinline__ float red8(float v) {
    v += dpp_<0xB1, 0xF>(0.f, v); v += dpp_<0x4E, 0xF>(0.f, v); v += dpp_<0x141, 0xF>(0.f, v);
    return v;
}
__device__ __forceinline__ float red16(float v) { v = red8(v); v += dpp_<0x140, 0xF>(0.f, v); return v; }
__device__ __forceinline__ float logsigmoidf_(float x) { return fminf(x, 0.f) - __logf(1.0f + __expf(-fabsf(x))); }
__device__ __forceinline__ size_t tl(int row, int col, int K) { return (size_t)(row >> 8) * ((size_t)256 * K) + (size_t)(col >> 6) * (256 * 64) + (size_t)((row & 255) * 64 + (col & 63)); }
__device__ __forceinline__ float rstd_from_quarter(const v4f a, int ln) {
    float s = (a.x + a.y) + (a.z + a.w);
    s += __int_as_float(__builtin_amdgcn_ds_bpermute((ln ^ 16) << 2, __float_as_int(s))); s += __int_as_float(__builtin_amdgcn_ds_bpermute((ln ^ 32) << 2, __float_as_int(s)));
    return rsqrtf(s * (1.0f / DM) + EPS);
}
__device__ __forceinline__ float row_rstd4(const float* ssp, int row, int fq, int ln) {
    const v4f a = *(const v4f*)(ssp + (size_t)row * 16 + 4 * fq);
    float s = (a.x + a.y) + (a.z + a.w);
    s += __int_as_float(__builtin_amdgcn_ds_bpermute((ln ^ 16) << 2, __float_as_int(s))); s += __int_as_float(__builtin_amdgcn_ds_bpermute((ln ^ 32) << 2, __float_as_int(s)));
    return rsqrtf(s * (1.0f / DM) + EPS);
}
__device__ __forceinline__ float row_rstd(const float* ssp, int row) {
    const v4f* p = (const v4f*)(ssp + (size_t)row * 16);
    const v4f a = p[0], b = p[1], c = p[2], d = p[3];
    const float s = ((a.x + a.y) + (a.z + a.w)) + ((b.x + b.y) + (b.z + b.w)) + ((c.x + c.y) + (c.z + c.w)) + ((d.x + d.y) + (d.z + d.w));
    return rsqrtf(s * (1.0f / DM) + EPS);
}

namespace pg8 {
__device__ __forceinline__ f32x4 sigmoid4(f32x4 x) {
    const f32x4 z = x * (-1.4426950408889634f); f32x4 e;
    e[0] = __builtin_amdgcn_exp2f(z[0]); e[1] = __builtin_amdgcn_exp2f(z[1]); e[2] = __builtin_amdgcn_exp2f(z[2]); e[3] = __builtin_amdgcn_exp2f(z[3]);
    const f32x4 d = e + 1.0f; f32x4 r;
    r[0] = __builtin_amdgcn_rcpf(d[0]); r[1] = __builtin_amdgcn_rcpf(d[1]); r[2] = __builtin_amdgcn_rcpf(d[2]); r[3] = __builtin_amdgcn_rcpf(d[3]);
    return r;
}
struct EpiSwiglu {
    static constexpr bool PERM = true, AFTER_DRAIN = false;
    static __device__ __forceinline__ bool keep_acc(const Unit&) { return false; }
    bf16_t* O; const float* ssp;
    __device__ __forceinline__ void operator()(const f32x4 (&acc)[2][2][4][2], const Unit& u, int wr, int wc, int, int) const {
        int t_ = threadIdx.x; asm volatile("" : "+v"(t_)); const int fr = t_ & 15, fq = (t_ >> 4) & 3;
        const int row0 = u.pm * BM + wr * 64 + fr, col0 = u.pn * HALF + wc * 32 + 8 * fq;
        v4f pq[2][4];
#pragma unroll
        for (int ai = 0; ai < 2; ++ai)
#pragma unroll
            for (int m = 0; m < 4; ++m) pq[ai][m] = *(const v4f*)(ssp + (size_t)(row0 + ai * HALF + m * 16) * 16 + 4 * fq);
        asm volatile("" ::: "memory");
#pragma unroll
        for (int ai = 0; ai < 2; ++ai)
#pragma unroll
            for (int m = 0; m < 4; ++m) {
                const int row = row0 + ai * HALF + m * 16; const float rs = rstd_from_quarter(pq[ai][m], fq * 16 + fr);
                float h[8];
#pragma unroll
                for (int n = 0; n < 2; ++n) { const f32x4 g = acc[ai][0][m][n] * rs, uu = acc[ai][1][m][n] * rs; const f32x4 hv = (g * sigmoid4(g)) * uu;
                    h[n * 4 + 0] = hv[0]; h[n * 4 + 1] = hv[1]; h[n * 4 + 2] = hv[2]; h[n * 4 + 3] = hv[3]; }
                *(u32x4*)(O + tl(row, col0, FF)) = pack8(h);
            }
    }
};
struct EpiResid {
    static constexpr bool PERM = true, AFTER_DRAIN = false;
    static __device__ __forceinline__ bool keep_acc(const Unit&) { return false; }
    const float* x0; bf16_t* xb; float* ssp; float scale;
    __device__ __forceinline__ void operator()(const f32x4 (&acc)[2][2][4][2], const Unit& u, int wr, int wc, int, int) const {
        int t_ = threadIdx.x; asm volatile("" : "+v"(t_)); const int fr = t_ & 15, fq = (t_ >> 4) & 3;
        const int row0 = u.pm * BM + wr * 64 + fr, col0 = u.pn * BM + wc * 32 + 8 * fq;
        u32x4 old[2][4][2];
#pragma unroll
        for (int ai = 0; ai < 2; ++ai)
#pragma unroll
            for (int m = 0; m < 4; ++m)
#pragma unroll
                for (int bj = 0; bj < 2; ++bj) old[ai][m][bj] = *(const u32x4*)(xb + tl(row0 + ai * HALF + m * 16, col0 + bj * HALF, DM));
        asm volatile("" ::: "memory");
#pragma unroll
        for (int ai = 0; ai < 2; ++ai)
#pragma unroll
            for (int m = 0; m < 4; ++m) {
                const int row = row0 + ai * HALF + m * 16; float ss = 0.f;
#pragma unroll
                for (int bj = 0; bj < 2; ++bj) {
                    float b[8], v[8]; unpack8(old[ai][m][bj], b);
#pragma unroll
                    for (int n = 0; n < 2; ++n)
#pragma unroll
                        for (int i = 0; i < 4; ++i) { const float t = b[n * 4 + i] + acc[ai][bj][m][n][i] * scale; v[n * 4 + i] = t; ss += t * t; }
                    *(u32x4*)(xb + tl(row, col0 + bj * HALF, DM)) = pack8(v);
                }
                { const int ln = fq * 16 + fr; ss += shx_(ss, ln, 16); ss += shx_(ss, ln, 32); }
                if (fq == 0) ssp[(size_t)row * 16 + u.pn * 4 + wc] = ss;
            }
    }
};
struct EpiWin {
    static constexpr bool PERM = true, AFTER_DRAIN = false;
    static __device__ __forceinline__ bool keep_acc(const Unit&) { return false; }
    bf16_t* Z; bf16_t* QC; bf16_t* KC; bf16_t* VC; float* mif; const float* ssp; const float* cosT; const float* sinT; const float* gate_b;
    __device__ __forceinline__ void operator()(const f32x4 (&acc)[2][2][4][2], const Unit& u, int wr, int wc, int, int) const {
        int t_ = threadIdx.x; asm volatile("" : "+v"(t_)); const int fr = t_ & 15, fq = (t_ >> 4) & 3;
        const int row0 = u.pm * BM + wr * 64 + fr, tile = u.pn;
        const bool rot = tile >= 5 && tile <= 8;
#pragma unroll
        for (int ab = 0; ab < 4; ++ab) {
            const int ai = ab >> 1;
            v4f pq[2]; v4f cs[2][4];
#pragma unroll
            for (int mm = 0; mm < 2; ++mm) { const int row = row0 + ai * HALF + ((ab & 1) * 2 + mm) * 16;
                pq[mm] = *(const v4f*)(ssp + (size_t)row * 16 + 4 * fq);
                if (rot) { const v4f* cp = (const v4f*)(cosT + (size_t)row * 32 + 8 * fq); const v4f* sp = (const v4f*)(sinT + (size_t)row * 32 + 8 * fq);
                    cs[mm][0] = cp[0]; cs[mm][1] = cp[1]; cs[mm][2] = sp[0]; cs[mm][3] = sp[1]; } }
            asm volatile("" ::: "memory");
#pragma unroll
            for (int mm = 0; mm < 2; ++mm) { const int m = (ab & 1) * 2 + mm;
                const int row = row0 + ai * HALF + m * 16; const float rs = rstd_from_quarter(pq[mm], fq * 16 + fr);
                float v0[8], v1[8];
#pragma unroll
                for (int n = 0; n < 2; ++n)
#pragma unroll
                    for (int i = 0; i < 4; ++i) { v0[n * 4 + i] = acc[ai][0][m][n][i] * rs; v1[n * 4 + i] = acc[ai][1][m][n][i] * rs; }
                bf16_t* zr = Z + (size_t)row * ZP + (tile < 5 ? tile : 0) * 256;
                const int bl_ = row >> 12, sq_ = row & (SEQ - 1);
                if (tile >= 5 && tile <= 8) {
                    const v4f c0 = cs[mm][0], c1 = cs[mm][1], s0 = cs[mm][2], s1 = cs[mm][3];
                    const float cc[8] = {c0.x, c0.y, c0.z, c0.w, c1.x, c1.y, c1.z, c1.w}, sn[8] = {s0.x, s0.y, s0.z, s0.w, s1.x, s1.y, s1.z, s1.w};
                    const float qs = tile < 7 ? QC2 : 1.0f;
                    float o0[8], o1[8];
#pragma unroll
                    for (int i = 0; i < 8; ++i) { o0[i] = (v0[i] * cc[i] - v1[i] * sn[i]) * qs; o1[i] = (v1[i] * cc[i] + v0[i] * sn[i]) * qs; }
                    bf16_t* dst = (tile < 7 ? QC : KC) + ((size_t)((bl_ * 8 + ((tile - 5) & 1) * 4 + wc) * SEQ + sq_)) * 64 + 8 * fq;
                    *(u32x4*)(dst) = pack8(o0);
                    *(u32x4*)(dst + 32) = pack8(o1);
                } else if (tile == 23) {
                    if (wc == 0 && fq == 0) {
                        float* mo = mif + (size_t)row * 8;
                        *(v4f*)(mo) = (v4f){v0[0] + gate_b[0], v0[1] + gate_b[1], v0[2] + gate_b[2], v0[3] + gate_b[3]};
                        *(v4f*)(mo + 4) = (v4f){v0[4] + gate_b[4], v0[5] + gate_b[5], v0[6] + gate_b[6], v0[7] + gate_b[7]};
                    }
                } else if (tile == 9 || tile == 10) {
                    bf16_t* d0 = VC + ((size_t)(((bl_ * 4 + (tile - 9) * 2 + 0) * 2 + (wc >> 1)) * SEQ + sq_)) * 64 + (wc & 1) * 32 + 8 * fq;
                    bf16_t* d1 = VC + ((size_t)(((bl_ * 4 + (tile - 9) * 2 + 1) * 2 + (wc >> 1)) * SEQ + sq_)) * 64 + (wc & 1) * 32 + 8 * fq;
                    *(u32x4*)d0 = pack8(v0); *(u32x4*)d1 = pack8(v1);
                } else {
                    if (tile >= 11) {
                        v2u q0, q1;
#pragma unroll
                        for (int n = 0; n < 2; ++n) { const f32x4 s0 = sigmoid4((f32x4){v0[n * 4], v0[n * 4 + 1], v0[n * 4 + 2], v0[n * 4 + 3]}) * 255.0f, s1 = sigmoid4((f32x4){v1[n * 4], v1[n * 4 + 1], v1[n * 4 + 2], v1[n * 4 + 3]}) * 255.0f;
                            const unsigned a = (unsigned)__builtin_rintf(s0[0]) | ((unsigned)__builtin_rintf(s0[1]) << 8) | ((unsigned)__builtin_rintf(s0[2]) << 16) | ((unsigned)__builtin_rintf(s0[3]) << 24);
                            const unsigned b = (unsigned)__builtin_rintf(s1[0]) | ((unsigned)__builtin_rintf(s1[1]) << 8) | ((unsigned)__builtin_rintf(s1[2]) << 16) | ((unsigned)__builtin_rintf(s1[3]) << 24);
                            if (n == 0) { q0.x = a; q1.x = b; } else { q0.y = a; q1.y = b; } }
                        unsigned char* gp = (unsigned char*)Z + (size_t)row * ZPB + ZGATE_B + (tile - 11) * 256 + wc * 32 + 8 * fq;
                        *(v2u*)gp = q0; *(v2u*)(gp + HALF) = q1;
                    } else {
                    *(u32x4*)(zr + wc * 32 + 8 * fq) = pack8(v0);
                    *(u32x4*)(zr + HALF + wc * 32 + 8 * fq) = pack8(v1);
                    }
                }
            }
            asm volatile("" ::: "memory");
        }
    }
};
struct EpiMerge {
    static constexpr bool PERM = true, AFTER_DRAIN = false;
    static __device__ __forceinline__ bool keep_acc(const Unit& u) { return (u.pm >> 6) == 2; }
    const bf16_t* Z; bf16_t* Mg;
    __device__ __forceinline__ void operator()(const f32x4 (&acc)[2][2][4][2], const Unit& u, int wr, int wc, int, int) const {
        int t_ = threadIdx.x; asm volatile("" : "+v"(t_)); const int fr = t_ & 15, fq = (t_ >> 4) & 3;
        const int br = u.pm >> 6, pm = u.pm & 63, pn = u.pn & 3, gb = br < 2 ? br : 2;
        const unsigned char* Zg = (const unsigned char*)Z + ZGATE_B + gb * 1024;
        const int row0 = pm * BM + wr * 64 + fr, col0 = pn * BM + wc * 32 + 8 * fq;
#pragma unroll
        for (int ai = 0; ai < 2; ++ai) {
            v2u gq[4][2]; u32x4 mo[4][2];
#pragma unroll
            for (int m = 0; m < 4; ++m)
#pragma unroll
                for (int bj = 0; bj < 2; ++bj) { const int row = row0 + ai * HALF + m * 16;
                    gq[m][bj] = *(const v2u*)(Zg + (size_t)row * ZPB + col0 + bj * HALF);
                    if (br != 0) mo[m][bj] = *(const u32x4*)(Mg + tl(row, col0 + bj * HALF, DM)); }
            asm volatile("" ::: "memory");
#pragma unroll
            for (int m = 0; m < 4; ++m) {
                const int row = row0 + ai * HALF + m * 16;
#pragma unroll
                for (int bj = 0; bj < 2; ++bj) {
                    float g[8], o[8];
                    { const v2u q = gq[m][bj]; const float k = 1.0f / 255.0f;
                      g[0] = (float)(q.x & 255u) * k; g[1] = (float)((q.x >> 8) & 255u) * k; g[2] = (float)((q.x >> 16) & 255u) * k; g[3] = (float)(q.x >> 24) * k;
                      g[4] = (float)(q.y & 255u) * k; g[5] = (float)((q.y >> 8) & 255u) * k; g[6] = (float)((q.y >> 16) & 255u) * k; g[7] = (float)(q.y >> 24) * k; }
#pragma unroll
                    for (int n = 0; n < 2; ++n)
#pragma unroll
                        for (int i = 0; i < 4; ++i) o[n * 4 + i] = g[n * 4 + i] * acc[ai][bj][m][n][i];
                    if (br != 0) { float p[8]; unpack8(mo[m][bj], p);
#pragma unroll
                        for (int i = 0; i < 8; ++i) o[i] += p[i]; }
                    *(u32x4*)(Mg + tl(row, col0 + bj * HALF, DM)) = pack8(o);
                }
            }
            asm volatile("" ::: "memory");
        }
    }
};
struct MergeOrder {
    StaticOrder base;
    __device__ void init(int M, int N, int G_, int c_) { base.init(M, N, G_, c_); }
    __device__ bool next(int i, Unit& u) const { Unit t; if (!base.next(i >> 2, t)) return false; const int br = i & 3; u.pm = br * 64 + t.pm; u.pn = br * 4 + t.pn; return true; }
    __device__ __forceinline__ void a_ready(const Unit&) const {}
    __device__ __forceinline__ void done(const Unit&) const {}
};
}

__device__ __forceinline__ int map_w13(int n) { const int u = n >= FF ? 1 : 0; const int j = n - u * FF; return 256 * (j >> 7) + 128 * u + (j & 127); }
__device__ __forceinline__ int map_win(int n) {
    if (n < 1280) return n;
    if (n < 1288) return 23 * 256 + (n - 1280);
    if (n < 2312) { const int c = n - 1288, tile = 5 + (c >> 8), cl = c & 255, hh = cl >> 6, r = cl & 63; return tile * 256 + (r >> 5) * 128 + hh * 32 + (r & 31); }
    if (n < 2824) return 9 * 256 + (n - 2312);
    return 11 * 256 + (n - 2824);
}
template <int MAP> __device__ __forceinline__ void transpose_item(const float* __restrict__ W, const float* __restrict__ gk, int K, int N, u16* __restrict__ WT, LAS float* scr, int item, int lane) {
    const int nblk = (N + 31) >> 5, kb = item / nblk, nb = item - kb * nblk, k0 = 64 * kb, n0 = 32 * nb;
    const int nn = n0 + (lane & 31); const bool ok = nn < N;
    float wv[32];
#pragma unroll
    for (int i = 0; i < 32; ++i) { const int kk = 2 * i + (lane >> 5); wv[i] = ok ? W[(size_t)(k0 + kk) * N + nn] : 0.f; }
#pragma unroll
    for (int i = 0; i < 32; ++i) { const int kk = 2 * i + (lane >> 5); float w = wv[i]; if (gk) w *= gk[k0 + kk]; scr[kk * 33 + (lane & 31)] = w; }
    asm volatile("s_waitcnt lgkmcnt(0)" ::: "memory");
    const int c = lane & 7;
#pragma unroll
    for (int j = 0; j < 4; ++j) { const int n = (lane >> 3) + 8 * j; const LAS float* s = scr + (8 * c) * 33 + n;
        if (n0 + n < N) {
            const int dest = MAP == 1 ? map_w13(n0 + n) : (MAP == 2 ? map_win(n0 + n) : (n0 + n));
            v4u o; o.x = pk2(s[0 * 33], s[1 * 33]); o.y = pk2(s[2 * 33], s[3 * 33]); o.z = pk2(s[4 * 33], s[5 * 33]); o.w = pk2(s[6 * 33], s[7 * 33]);
            *(v4u*)(WT + tl(dest, k0 + 8 * c, K)) = o; } }
    asm volatile("s_waitcnt lgkmcnt(0)" ::: "memory");
}

struct Args { const void* in[23]; float* out; unsigned char* ws; };

__device__ __forceinline__ void prologue(const Args& A, unsigned char* ws, LAS unsigned char* lds, int gw, int NGW, int wave, int lane) {
    LAS float* scr = (LAS float*)(lds + wave * 16384);
    int base = 0;
    for (int l = 0; l < NLAYER; ++l) {
        unsigned char* wl = ws + WS_W + (size_t)l * W_LSTRIDE;
        const float* n1 = (const float*)A.in[2] + l * DM; const float* nm = (const float*)A.in[5] + l * DM; const float* n2 = (const float*)A.in[19] + l * DM;
        { const int nit = 16 * 176; for (int it = (gw - base + NGW) % NGW; it < nit; it += NGW) transpose_item<1>((const float*)A.in[3] + (size_t)l * DM * 2 * FF, n1, DM, 2 * FF, (u16*)(wl + WO_13A), scr, it, lane); base = (base + nit) % NGW; }
        { const int nit = 44 * 32;  for (int it = (gw - base + NGW) % NGW; it < nit; it += NGW) transpose_item<0>((const float*)A.in[4] + (size_t)l * FF * DM, nullptr, FF, DM, (u16*)(wl + WO_2A), scr, it, lane); base = (base + nit) % NGW; }
        { const int nit = 16 * 185; for (int it = (gw - base + NGW) % NGW; it < nit; it += NGW) transpose_item<2>((const float*)A.in[6] + (size_t)l * DM * NIN, nm, DM, NIN, (u16*)(wl + WO_IN), scr, it, lane); base = (base + nit) % NGW; }
        { const int nit = 4 * 32;   for (int it = (gw - base + NGW) % NGW; it < nit; it += NGW) transpose_item<0>((const float*)A.in[15] + (size_t)l * 256 * DM, nullptr, 256, DM, (u16*)(wl + WO_PA), scr, it, lane); base = (base + nit) % NGW; }
        { const int nit = 4 * 32;   for (int it = (gw - base + NGW) % NGW; it < nit; it += NGW) transpose_item<0>((const float*)A.in[16] + (size_t)l * 256 * DM, nullptr, 256, DM, (u16*)(wl + WO_PB), scr, it, lane); base = (base + nit) % NGW; }
        { const int nit = 4 * 32;   for (int it = (gw - base + NGW) % NGW; it < nit; it += NGW) transpose_item<0>((const float*)A.in[17] + (size_t)l * 512 * DM, nullptr, 256, DM, (u16*)(wl + WO_PC), scr, it, lane); base = (base + nit) % NGW; }
        { const int nit = 4 * 32;   for (int it = (gw - base + NGW) % NGW; it < nit; it += NGW) transpose_item<0>((const float*)A.in[17] + (size_t)l * 512 * DM + (size_t)256 * DM, nullptr, 256, DM, (u16*)(wl + WO_PC + 512 * KiB), scr, it, lane); base = (base + nit) % NGW; }
        { const int nit = 16 * 32;  for (int it = (gw - base + NGW) % NGW; it < nit; it += NGW) transpose_item<0>((const float*)A.in[18] + (size_t)l * DM * DM, nullptr, DM, DM, (u16*)(wl + WO_OUT), scr, it, lane); base = (base + nit) % NGW; }
        { const int nit = 16 * 176; for (int it = (gw - base + NGW) % NGW; it < nit; it += NGW) transpose_item<1>((const float*)A.in[20] + (size_t)l * DM * 2 * FF, n2, DM, 2 * FF, (u16*)(wl + WO_13B), scr, it, lane); base = (base + nit) % NGW; }
        { const int nit = 44 * 32;  for (int it = (gw - base + NGW) % NGW; it < nit; it += NGW) transpose_item<0>((const float*)A.in[21] + (size_t)l * FF * DM, nullptr, FF, DM, (u16*)(wl + WO_2B), scr, it, lane); base = (base + nit) % NGW; }
        { u16* z0 = (u16*)(wl + WO_IN) + (size_t)23 * 256 * DM; const int nch = 16 * 248 * 8;
          for (int i = gw * 64 + lane; i < nch; i += NGW * 64) { const int kb = i / (248 * 8), r = i - kb * (248 * 8); *(v4u*)(z0 + (size_t)kb * (256 * 64) + 8 * 64 + (size_t)r * 8) = (v4u){0u, 0u, 0u, 0u}; } }
    }
    const float* x = (const float*)A.in[0]; const int* pos = (const int*)A.in[1];
    u16* xb = (u16*)(ws + WS_XB); float* ssp = (float*)(ws + WS_SSP); float* cosT = (float*)(ws + WS_COS); float* sinT = (float*)(ws + WS_SIN);
    for (int row = gw; row < MROWS; row += NGW) {
        const v4f* xr = (const v4f*)(x + (size_t)row * DM) + lane; v4f v[4]; float s = 0.f;
#pragma unroll
        for (int j = 0; j < 4; ++j) { v[j] = xr[64 * j]; s += (v[j].x * v[j].x + v[j].y * v[j].y) + (v[j].z * v[j].z + v[j].w * v[j].w); }
        s = wave_sum(s, lane);
#pragma unroll
        for (int j = 0; j < 4; ++j) { v2u w; w.x = pk2(v[j].x, v[j].y); w.y = pk2(v[j].z, v[j].w); *(v2u*)(xb + tl(row, 4 * lane + 256 * j, DM)) = w; }
        if (lane < 16) ssp[(size_t)row * 16 + lane] = lane == 0 ? s : 0.f;
        if (lane < 32) { const float inv = 1.0f / powf(10000.0f, (float)lane * (1.0f / 32.0f)); const float ang = (float)pos[row] * inv; cosT[(size_t)row * 32 + lane] = cosf(ang); sinT[(size_t)row * 32 + lane] = sinf(ang); }
    }
}

#define LBAR() do { asm volatile("s_waitcnt lgkmcnt(0)" ::: "memory"); __builtin_amdgcn_s_barrier(); asm volatile("" ::: "memory"); } while (0)
constexpr int CWL_OFF = 100 * 1024;
__device__ __forceinline__ void stage_conv_weights(const float* cw, const float* cb, LAS unsigned char* lds, int tid) {
    LAS float* L = (LAS float*)(lds + CWL_OFF);
    const float a0 = cw[tid], a1 = cw[tid + 512], a2 = cw[tid + 1024], a3 = cw[tid + 1536], b0 = cb[tid & 511];
    L[tid] = a0; L[tid + 512] = a1; L[tid + 1024] = a2; L[tid + 1536] = a3; L[2048 + (tid & 511)] = b0;
    LBAR();
}
struct PoolIn { v4u u0, u1; v4f w0, w1; };
__device__ __forceinline__ PoolIn pool_load(const u16* Z, const float* pw, int un, int tid) {
    const int g = un >> 8, tb = un & 63, bl = (un >> 6) & 3; const int r0 = bl * SEQ + tb * 64;
    const int rr = tid >> 3, cg8 = (tid & 7) * 8;
    PoolIn I; const bool ok0 = tb * 64 - 16 + rr >= 0;
    I.u0 = *(const v4u*)(Z + (size_t)(ok0 ? r0 - 16 + rr : r0) * ZP + g * 64 + cg8);
    I.u1 = *(const v4u*)(Z + (size_t)(r0 + 48 + (rr & 15)) * ZP + g * 64 + cg8);
    I.w0 = *(const v4f*)(pw + g * 4096 + tid * 8); I.w1 = *(const v4f*)(pw + g * 4096 + tid * 8 + 4);
    return I;
}
__device__ __forceinline__ void pool_compute(const PoolIn& I, u16* YA, const float* pscale, LAS unsigned char* lds, int un, int tid) {
    const int g = un >> 8, tb = un & 63, bl = (un >> 6) & 3; const int r0 = bl * SEQ + tb * 64;
    constexpr int PLP = 72;
    LAS float* Uf = (LAS float*)lds;
    LAS u16* Pb = (LAS u16*)(lds + 20800);
    LAS u16* WgT = Pb + 64 * PLP;
    const int rr = tid >> 3, cg8 = (tid & 7) * 8, lane = tid & 63, wave = tid >> 6;
    { float x[8]; unpack8(I.u0, x); const float keep0 = tb * 64 - 16 + rr >= 0 ? 1.0f : 0.0f;
#pragma unroll
      for (int i = 0; i < 8; ++i) Uf[rr * 65 + cg8 + i] = x[i] * keep0;
      if (rr < 16) { unpack8(I.u1, x);
#pragma unroll
        for (int i = 0; i < 8; ++i) Uf[(rr + 64) * 65 + cg8 + i] = x[i]; }
      const float wv[8] = {I.w0.x, I.w0.y, I.w0.z, I.w0.w, I.w1.x, I.w1.y, I.w1.z, I.w1.w};
#pragma unroll
      for (int i = 0; i < 8; ++i) WgT[(cg8 + i) * PLP + rr] = (u16)f2bf(wv[i]); }
    LBAR();
    { const int w = 2 << g, t = rr, tpos = tb * 64 + t; const float rc = 1.0f / (float)(tpos + 1 < w ? tpos + 1 : w);
        float s[8], u0[8];
#pragma unroll
        for (int i = 0; i < 8; ++i) { u0[i] = Uf[(16 + t) * 65 + cg8 + i]; s[i] = u0[i] + Uf[(15 + t) * 65 + cg8 + i]; }
        if (g >= 1) {
#pragma unroll
            for (int i = 0; i < 8; ++i) s[i] += Uf[(14 + t) * 65 + cg8 + i] + Uf[(13 + t) * 65 + cg8 + i]; }
        if (g >= 2) {
#pragma unroll
            for (int i = 0; i < 8; ++i) s[i] += (Uf[(12 + t) * 65 + cg8 + i] + Uf[(11 + t) * 65 + cg8 + i]) + (Uf[(10 + t) * 65 + cg8 + i] + Uf[(9 + t) * 65 + cg8 + i]); }
        if (g >= 3) {
#pragma unroll
            for (int i = 0; i < 8; ++i) { float a = 0.f;
#pragma unroll
                for (int j = 8; j < 16; ++j) a += Uf[(16 + t - j) * 65 + cg8 + i];
                s[i] += a; } }
        float p[8];
#pragma unroll
        for (int i = 0; i < 8; ++i) p[i] = s[i] * rc - u0[i];
        *(LAS v4u*)(Pb + t * PLP + cg8) = pack8(p); }
    LBAR();
    {
        const int tr = wave >> 1, tc0 = (wave & 1) * 2, fr = lane & 15, fq = lane >> 4;
        v4f a0 = {0.f, 0.f, 0.f, 0.f}, a1 = {0.f, 0.f, 0.f, 0.f};
#pragma unroll
        for (int kk = 0; kk < 2; ++kk) { const v8s a = *(const LAS v8s*)(Pb + (16 * tr + fr) * PLP + 32 * kk + 8 * fq);
            a0 = __builtin_amdgcn_mfma_f32_16x16x32_bf16(a, *(const LAS v8s*)(WgT + (16 * tc0 + fr) * PLP + 32 * kk + 8 * fq), a0, 0, 0, 0);
            a1 = __builtin_amdgcn_mfma_f32_16x16x32_bf16(a, *(const LAS v8s*)(WgT + (16 * tc0 + 16 + fr) * PLP + 32 * kk + 8 * fq), a1, 0, 0, 0); }
#pragma unroll
        for (int rg = 0; rg < 4; ++rg) { const int t = 16 * tr + 4 * fq + rg; Uf[t * 65 + 16 * tc0 + fr] = a0[rg]; Uf[t * 65 + 16 * tc0 + 16 + fr] = a1[rg]; } }
    LBAR();
    { const int t = rr; float o[8];
#pragma unroll
        for (int i = 0; i < 8; ++i) o[i] = Uf[t * 65 + cg8 + i] * pscale[g * 64 + cg8 + i];
        *(v4u*)(YA + tl(r0 + t, g * 64 + cg8, 256)) = pack8(o); }
    LBAR();
}

__device__ __forceinline__ void conv8r(const v4u* rows, const LAS float* cwL, int ch0, float* o, int tpos) {
#pragma unroll
    for (int i = 0; i < 8; ++i) o[i] = cwL[2048 + ch0 + i];
#pragma unroll
    for (int j = 0; j < 4; ++j) { float x[8]; unpack8(rows[j], x); const float keep = tpos - 3 + j >= 0 ? 1.0f : 0.0f;
#pragma unroll
        for (int i = 0; i < 8; ++i) o[i] += cwL[j * 512 + ch0 + i] * (x[i] * keep); }
#pragma unroll
    for (int i = 0; i < 8; ++i) o[i] = siluf_(o[i]);
}
__device__ __forceinline__ void load4rows(const u16* Z, int r, int tpos, int zcol, v4u* rows) {
#pragma unroll
    for (int j = 0; j < 4; ++j) { const bool ok = tpos - 3 + j >= 0; rows[j] = *(const v4u*)(Z + (size_t)(ok ? r - 3 + j : r) * ZP + zcol); }
}
constexpr int LP = 72;
__device__ __forceinline__ v8s lds_frag(const LAS u16* base, int row, int koff) { return *(const LAS v8s*)(base + row * LP + koff); }

struct M1In { v4u k[4]; v4u v; float ip, fp; };
__device__ __forceinline__ M1In m1_load(const u16* Z, const float* mif, int un, int tid) {
    const int c = un & 63, h = (un >> 6) & 3, bl = un >> 8; const int r0 = bl * SEQ + c * 64;
    const int s = tid >> 3, dg = tid & 7;
    M1In I; load4rows(Z, r0 + s, c * 64 + s, 2 * 256 + h * 64 + dg * 8, I.k);
    I.v = *(const v4u*)(Z + (size_t)(r0 + s) * ZP + 3 * 256 + h * 64 + dg * 8);
    I.ip = mif[(size_t)(r0 + (tid & 63)) * 8 + h]; I.fp = mif[(size_t)(r0 + (tid & 63)) * 8 + 4 + h];
    return I;
}
__device__ __forceinline__ void m1_compute(const M1In& I, float* U, float* nU, float* mlv, float* blv, LAS unsigned char* lds, int un, int tid) {
    const int h = (un >> 6) & 3;
    const int lane = tid & 63, wave = tid >> 6;
    LAS float* wk = (LAS float*)lds;
    LAS u16* Vt = (LAS u16*)(lds + 1024);
    LAS u16* KWt = Vt + 64 * LP;
    const LAS float* cwL = (const LAS float*)(lds + CWL_OFF);
    if (wave == 0) {
        const float bc = wave_incl_sum(logsigmoidf_(I.fp), lane); const float blast = lane63_(bc);
        const float g = blast - bc + I.ip; const float mx = wave_max(g, lane);
        wk[lane] = __expf(g - mx);
        if (lane == 0) { wk[64] = mx; wk[65] = blast; }
    }
    const int s = tid >> 3, dg = tid & 7;
    float kv[8]; conv8r(I.k, cwL, 256 + h * 64 + dg * 8, kv, (un & 63) * 64 + s);
    float vv[8]; unpack8(I.v, vv);
    LBAR();
    { const float w = wk[s] * 0.125f;
#pragma unroll
        for (int i = 0; i < 8; ++i) { KWt[(dg * 8 + i) * LP + s] = (u16)f2bf(kv[i] * w); Vt[(dg * 8 + i) * LP + s] = (u16)f2bf(vv[i]); } }
    LBAR();
    { const int tr = wave >> 1, tc0 = (wave & 1) * 2, fr = lane & 15, fq = lane >> 4;
        v4f a0 = {0.f, 0.f, 0.f, 0.f}, a1 = {0.f, 0.f, 0.f, 0.f};
#pragma unroll
        for (int kk = 0; kk < 2; ++kk) { const v8s a = lds_frag(Vt, 16 * tr + fr, 32 * kk + 8 * fq);
            a0 = __builtin_amdgcn_mfma_f32_16x16x32_bf16(a, lds_frag(KWt, 16 * tc0 + fr, 32 * kk + 8 * fq), a0, 0, 0, 0);
            a1 = __builtin_amdgcn_mfma_f32_16x16x32_bf16(a, lds_frag(KWt, 16 * tc0 + 16 + fr, 32 * kk + 8 * fq), a1, 0, 0, 0); }
        float* Uo = U + (size_t)un * 4096;
#pragma unroll
        for (int rg = 0; rg < 4; ++rg) { const int e = 16 * tr + 4 * fq + rg; Uo[e * 64 + 16 * tc0 + fr] = a0[rg]; Uo[e * 64 + 16 * tc0 + 16 + fr] = a1[rg]; } }
    { float x[8]; unpack8(*(const LAS v4u*)(KWt + s * LP + dg * 8), x); float sN = ((x[0] + x[1]) + (x[2] + x[3])) + ((x[4] + x[5]) + (x[6] + x[7]));
      sN = red8(sN); if (dg == 0) nU[un * 64 + s] = sN; }
    if (tid == 0) { mlv[un] = wk[64]; blv[un] = wk[65]; }
    LBAR();
}

__device__ __forceinline__ void m2_phase(const float* __restrict__ U, const float* __restrict__ nU, const float* __restrict__ mlv, const float* __restrict__ blv,
                                         u16* __restrict__ Cst, float* __restrict__ nst, float* __restrict__ mst, LAS unsigned char* lds, int G, int bx, int tid) {
    const int per = (16 * 4160 + G - 1) / G, e0 = bx * per;
    const int pfirst = e0 / 4160;
    LAS float* decs = (LAS float*)lds; LAS float* scs = decs + 128;
    const int lane = tid & 63, wave = tid >> 6;
    if (wave < 2 && pfirst + wave < 16) {
        const int un = (pfirst + wave) * 64 + lane; const float ml = mlv[un], b = blv[un];
        const float Bincl = wave_incl_sum(b, lane);
        const float Mnext = fmaxf(0.f, wave_incl_max(ml - Bincl, lane));
        float Mcur = shl_(Mnext, (lane - 1) & 63); if (lane == 0) Mcur = 0.f;
        const float mcur = Mcur + (Bincl - b), mnext = Mnext + Bincl;
        decs[wave * 64 + lane] = __expf(b + mcur - mnext); scs[wave * 64 + lane] = __expf(ml - mnext);
        mst[un] = mcur;
    }
    LBAR();
    for (int t = tid; t < per; t += NTHR) { const int gt = e0 + t; if (gt < 16 * 4160) {
        const int p = gt / 4160, idx = gt - p * 4160, w = (p - pfirst) * 64; float st = 0.f;
        if (idx < 4096) { const float* up = U + (size_t)p * 64 * 4096 + idx; u16* cp = Cst + (size_t)p * 64 * 4096 + idx;
            float uv[64];
#pragma unroll
            for (int c = 0; c < 64; ++c) uv[c] = up[(size_t)c * 4096];
#pragma unroll
            for (int c = 0; c < 64; ++c) { cp[(size_t)c * 4096] = (u16)f2bf(st); st = decs[w + c] * st + scs[w + c] * uv[c]; } }
        else { const float* up = nU + p * 64 * 64 + idx - 4096; float* np = nst + p * 64 * 64 + idx - 4096;
            float uv[64];
#pragma unroll
            for (int c = 0; c < 64; ++c) uv[c] = up[c * 64];
            asm volatile("" ::: "memory");
#pragma unroll
            for (int c = 0; c < 64; ++c) { np[c * 64] = st; st = decs[w + c] * st + scs[w + c] * uv[c]; } } } }
    LBAR();
}

struct M3In { v4u q[4], k[4], v, c, mo; float ip, fp, nvv, mc; };
__device__ __forceinline__ M3In m3_load(const u16* Z, const float* mif, const u16* Cst, const float* nst, const float* mst, int un, int tid) {
    const int c = un & 63, h = (un >> 6) & 3, bl = un >> 8; const int r0 = bl * SEQ + c * 64;
    const int s = tid >> 3, dg = tid & 7;
    M3In I; load4rows(Z, r0 + s, c * 64 + s, 1 * 256 + h * 64 + dg * 8, I.q); load4rows(Z, r0 + s, c * 64 + s, 2 * 256 + h * 64 + dg * 8, I.k);
    I.v = *(const v4u*)(Z + (size_t)(r0 + s) * ZP + 3 * 256 + h * 64 + dg * 8);
    I.mo = *(const v4u*)(Z + (size_t)(r0 + s) * ZP + 4 * 256 + h * 64 + dg * 8);
    I.c = *(const v4u*)(Cst + (size_t)un * 4096 + s * 64 + dg * 8);
    I.ip = mif[(size_t)(r0 + (tid & 63)) * 8 + h]; I.fp = mif[(size_t)(r0 + (tid & 63)) * 8 + 4 + h]; I.nvv = nst[un * 64 + (tid & 63)]; I.mc = mst[un];
    return I;
}
__device__ __forceinline__ void m3_compute(const M3In& I, const float* mnorm, u16* YB, LAS unsigned char* lds, int un, int tid) {
    const int c = un & 63, h = (un >> 6) & 3, bl = un >> 8; const int r0 = bl * SEQ + c * 64;
    const int lane = tid & 63, wave = tid >> 6;
    LAS float* av = (LAS float*)lds;
    LAS float* Mx = av + 64;
    LAS float* wi = Mx + 64;
    LAS float* emt = wi + 64;
    LAS float* nv = emt + 64;
    LAS float* dinv = nv + 64;
    LAS u16* Qs = (LAS u16*)(lds + 2048);
    LAS u16* Ks = Qs + 64 * LP;
    LAS u16* Vt = Ks + 64 * LP;
    LAS u16* Cs = Vt + 64 * LP;
    LAS u16* SC = Cs + 64 * LP;
    LAS float* NUM = (LAS float*)(SC + 64 * LP);
    const LAS float* cwL = (const LAS float*)(lds + CWL_OFF);
    if (wave == 0) {
        const float mc = I.mc;
        const float bc = wave_incl_sum(logsigmoidf_(I.fp), lane);
        const float a = I.ip - bc; const float pm = wave_incl_max(a, lane); const float MM = fmaxf(mc, pm);
        av[lane] = a; Mx[lane] = MM; wi[lane] = __expf(mc - MM); emt[lane] = __expf(-bc - MM); nv[lane] = I.nvv;
    }
    const int s = tid >> 3, dg = tid & 7;
    { float q[8], k[8], v[8];
        conv8r(I.q, cwL, h * 64 + dg * 8, q, c * 64 + s);
        conv8r(I.k, cwL, 256 + h * 64 + dg * 8, k, c * 64 + s);
#pragma unroll
        for (int i = 0; i < 8; ++i) k[i] *= 0.125f;
        unpack8(I.v, v);
        *(LAS v4u*)(Qs + s * LP + dg * 8) = pack8(q);
        *(LAS v4u*)(Ks + s * LP + dg * 8) = pack8(k);
#pragma unroll
        for (int i = 0; i < 8; ++i) Vt[(dg * 8 + i) * LP + s] = (u16)f2bf(v[i]);
        *(LAS v4u*)(Cs + s * LP + dg * 8) = I.c; }
    LBAR();
    const int tr = wave >> 1, tc0 = (wave & 1) * 2, fr = lane & 15, fq = lane >> 4;
    {
        v4f a0 = {0.f, 0.f, 0.f, 0.f}, a1 = {0.f, 0.f, 0.f, 0.f};
#pragma unroll
        for (int kk = 0; kk < 2; ++kk) { const v8s a = lds_frag(Qs, 16 * tr + fr, 32 * kk + 8 * fq);
            a0 = __builtin_amdgcn_mfma_f32_16x16x32_bf16(a, lds_frag(Ks, 16 * tc0 + fr, 32 * kk + 8 * fq), a0, 0, 0, 0);
            a1 = __builtin_amdgcn_mfma_f32_16x16x32_bf16(a, lds_frag(Ks, 16 * tc0 + 16 + fr, 32 * kk + 8 * fq), a1, 0, 0, 0); }
#pragma unroll
        for (int rg = 0; rg < 4; ++rg) { const int t = 16 * tr + 4 * fq + rg; const float mt = Mx[t];
            const int s0 = 16 * tc0 + fr, s1 = s0 + 16;
            const float w0 = s0 <= t ? __expf(av[s0] - mt) : 0.f, w1 = s1 <= t ? __expf(av[s1] - mt) : 0.f;
            SC[t * LP + s0] = (u16)f2bf(a0[rg] * w0); SC[t * LP + s1] = (u16)f2bf(a1[rg] * w1); } }
    LBAR();
    {
        v4f a0 = {0.f, 0.f, 0.f, 0.f}, a1 = {0.f, 0.f, 0.f, 0.f}, c0 = {0.f, 0.f, 0.f, 0.f}, c1 = {0.f, 0.f, 0.f, 0.f};
#pragma unroll
        for (int kk = 0; kk < 2; ++kk) { const v8s a = lds_frag(SC, 16 * tr + fr, 32 * kk + 8 * fq), q = lds_frag(Qs, 16 * tr + fr, 32 * kk + 8 * fq);
            a0 = __builtin_amdgcn_mfma_f32_16x16x32_bf16(a, lds_frag(Vt, 16 * tc0 + fr, 32 * kk + 8 * fq), a0, 0, 0, 0);
            a1 = __builtin_amdgcn_mfma_f32_16x16x32_bf16(a, lds_frag(Vt, 16 * tc0 + 16 + fr, 32 * kk + 8 * fq), a1, 0, 0, 0);
            c0 = __builtin_amdgcn_mfma_f32_16x16x32_bf16(q, lds_frag(Cs, 16 * tc0 + fr, 32 * kk + 8 * fq), c0, 0, 0, 0);
            c1 = __builtin_amdgcn_mfma_f32_16x16x32_bf16(q, lds_frag(Cs, 16 * tc0 + 16 + fr, 32 * kk + 8 * fq), c1, 0, 0, 0); }
#pragma unroll
        for (int rg = 0; rg < 4; ++rg) { const int t = 16 * tr + 4 * fq + rg; const float w = wi[t];
            NUM[t * 65 + 16 * tc0 + fr] = a0[rg] + w * c0[rg]; NUM[t * 65 + 16 * tc0 + 16 + fr] = a1[rg] + w * c1[rg]; } }
    { const int t = s; float a[8], q[8]; unpack8(*(const LAS v4u*)(SC + t * LP + dg * 8), a); unpack8(*(const LAS v4u*)(Qs + t * LP + dg * 8), q);
        float rs = ((a[0] + a[1]) + (a[2] + a[3])) + ((a[4] + a[5]) + (a[6] + a[7])), qn = 0.f;
#pragma unroll
        for (int i = 0; i < 8; ++i) qn += q[i] * nv[dg * 8 + i];
        rs = red8(rs); qn = red8(qn);
        if (dg == 0) { const float den = rs + wi[t] * qn; dinv[t] = 1.0f / fmaxf(fabsf(den), emt[t]); } }
    LBAR();
    {
        const int t = s; const float di = dinv[t]; float hv[8]; float sm = 0.f;
#pragma unroll
        for (int i = 0; i < 8; ++i) { hv[i] = NUM[t * 65 + dg * 8 + i] * di; sm += hv[i]; }
        sm = red8(sm);
        const float mu = sm * (1.0f / 64.0f); float vs = 0.f;
#pragma unroll
        for (int i = 0; i < 8; ++i) { hv[i] -= mu; vs += hv[i] * hv[i]; }
        vs = red8(vs);
        const float rstd = rsqrtf(vs * (1.0f / 64.0f) + EPS);
        float og[8]; unpack8(I.mo, og);
        float o[8];
#pragma unroll
        for (int i = 0; i < 8; ++i) o[i] = hv[i] * rstd * mnorm[h * 64 + dg * 8 + i] * sigmoidf_(og[i]);
        *(v4u*)(YB + tl(r0 + t, h * 64 + dg * 8, 256)) = pack8(o); }
    LBAR();
}

__device__ __forceinline__ void attn_post(const u16* O, u16* YC, const float* dlam, const float* dnorm, float lambda_init, int gt, int nthreads, int lane) {
    float sa = dlam[lane] * dlam[64 + lane], sb = dlam[128 + lane] * dlam[192 + lane];
    sa = wave_sum(sa, lane); sb = wave_sum(sb, lane);
    const float lam = expf(sa) - expf(sb) + lambda_init, post = 1.0f - lambda_init;
    const int sub = gt & 15;
    float gn[8];
#pragma unroll
    for (int i = 0; i < 8; ++i) gn[i] = dnorm[sub * 8 + i] * post;
    const int stride = nthreads >> 4;
    for (int item0 = gt >> 4; item0 < MH * 4; item0 += 8 * stride) {
        v4u ra[8], rb[8];
#pragma unroll
        for (int q = 0; q < 8; ++q) { const int item = item0 + q * stride < MH * 4 ? item0 + q * stride : item0; const int row = item >> 2, hh = item & 3;
            ra[q] = *(const v4u*)(O + (size_t)row * 1024 + (2 * hh) * 128 + sub * 8); rb[q] = *(const v4u*)(O + (size_t)row * 1024 + (2 * hh + 1) * 128 + sub * 8); }
#pragma unroll
        for (int q = 0; q < 8; ++q) { const int item = item0 + q * stride; const int row = item >> 2, hh = item & 3; float a[8], b[8], d[8]; float ss = 0.f;
            unpack8(ra[q], a); unpack8(rb[q], b);
#pragma unroll
            for (int i = 0; i < 8; ++i) { d[i] = a[i] - lam * b[i]; ss += d[i] * d[i]; }
            ss = red16(ss);
            const float r = rsqrtf(ss * (1.0f / 128.0f) + EPS);
#pragma unroll
            for (int i = 0; i < 8; ++i) d[i] *= r * gn[i];
            if (item < MH * 4) *(v4u*)(YC + (size_t)(hh >> 1) * MH * 256 + tl(row, (hh & 1) * 128 + sub * 8, 256)) = pack8(d); }
    }
}

#define RLX_AGENT __ATOMIC_RELAXED, __HIP_MEMORY_SCOPE_AGENT
#define XB_TMO      128
#define XB_XCNT(j)  (256  + 64 * (j))
#define XB_XSUB(j)  (1280 + 64 * (j))
#define XB_XGEN(j)  (2304 + 64 * (j))
#define XB_TOP      3328
#define XB_TOPGEN   3392
#define XCD_BAR_WORDS 3456
#define XB_SPIN_CAP (1u << 18)

__device__ __forceinline__ unsigned xb_ld(unsigned* p)              { return __hip_atomic_load(p, __ATOMIC_RELAXED, __HIP_MEMORY_SCOPE_AGENT); }
__device__ __forceinline__ unsigned xb_add(unsigned* p, unsigned v) { return __hip_atomic_fetch_add(p, v, __ATOMIC_RELAXED, __HIP_MEMORY_SCOPE_AGENT); }
__device__ __forceinline__ unsigned xb_xcc_id() { return (unsigned)__builtin_amdgcn_s_getreg((3 << 11) | 20) & 0xFu; }
#define XB_SPIN(cond, bar) do { unsigned _sp = 0; while (cond) { __builtin_amdgcn_s_sleep(1); \
    if ((++_sp & 255u) == 0u) { if (xb_ld(&(bar)[XB_TMO])) break; if (_sp > XB_SPIN_CAP) { atomicAdd(&(bar)[XB_TMO], 1u); break; } } } } while (0)

struct XcdBarrier {
    unsigned* bar; unsigned x;
    volatile LAS unsigned* st;
};

__device__ __forceinline__ XcdBarrier xcd_barrier_post(unsigned* bar, volatile LAS unsigned* st) {
    XcdBarrier b; b.bar = bar; b.x = xb_xcc_id(); b.st = st;
    if (threadIdx.x == 0) (void)xb_add(&bar[XB_XCNT(b.x)], 1u);
    return b;
}
__device__ __forceinline__ void xcd_barrier_complete(unsigned* bar, unsigned x, unsigned& nloc, unsigned& nx) {
    const unsigned G = gridDim.x * gridDim.y * gridDim.z;
    unsigned sum, cnt, mine, sp = 0u;
    for (;;) {
        sum = 0u; cnt = 0u; mine = 0u;
#pragma unroll
        for (unsigned j = 0; j < 16; ++j) { const unsigned c = xb_ld(&bar[XB_XCNT(j)]); sum += c; cnt += (c > 0u) ? 1u : 0u; mine = (j == x) ? c : mine; }
        if (sum == G) break;
        __builtin_amdgcn_s_sleep(1);
        if ((++sp & 255u) == 0u) { if (xb_ld(&bar[XB_TMO])) break; if (sp > XB_SPIN_CAP) { atomicAdd(&bar[XB_TMO], 1u); break; } }
    }
    nloc = mine > 0u ? mine : 1u; nx = cnt > 0u ? cnt : 1u;
}

__device__ __forceinline__ void xcd_barrier(const XcdBarrier& b) {
    asm volatile("s_waitcnt vmcnt(0)" ::: "memory");
    __syncthreads();
    if (threadIdx.x == 0) {
        unsigned* bar = b.bar;
        __builtin_amdgcn_s_waitcnt(0);
        unsigned nloc = b.st[0], nx = b.st[1];
        if (nloc == 0u) { xcd_barrier_complete(bar, b.x, nloc, nx); b.st[0] = nloc; b.st[1] = nx; }
        const unsigned old = xb_add(&bar[XB_XSUB(b.x)], 1u);
        const unsigned gen = old / nloc;
        if (old + 1u == (gen + 1u) * nloc) {
            __builtin_amdgcn_fence(__ATOMIC_RELEASE, "agent");
            asm volatile("s_waitcnt vmcnt(0)" ::: "memory");
            const unsigned og = xb_add(&bar[XB_TOP], 1u);
            const unsigned tg = og / nx;
            if (og + 1u == (tg + 1u) * nx) xb_add(&bar[XB_TOPGEN], 1u);
            else XB_SPIN(xb_ld(&bar[XB_TOPGEN]) == tg, bar);
            __builtin_amdgcn_fence(__ATOMIC_ACQUIRE, "agent");
            xb_add(&bar[XB_XGEN(b.x)], 1u);
            asm volatile("s_waitcnt vmcnt(0)" ::: "memory");
        } else {
            XB_SPIN(xb_ld(&bar[XB_XGEN(b.x)]) == gen, bar);
            __builtin_amdgcn_fence(__ATOMIC_ACQUIRE, "agent");
            asm volatile("s_waitcnt vmcnt(0)" ::: "memory");
        }
    }
    __syncthreads();
}


#ifndef SK0
#define SK0 0
#endif
#ifndef SK1
#define SK1 0
#endif
#ifndef SK2
#define SK2 0
#endif
#ifndef SK3
#define SK3 0
#endif
#ifndef SK4
#define SK4 0
#endif
#ifndef SK5
#define SK5 0
#endif
#ifndef SK6
#define SK6 0
#endif
#ifndef SKP
#define SKP 0
#endif
#ifndef REPMASK
#define REPMASK 0
#endif
#ifndef REPK1SEL
#define REPK1SEL 0
#endif
#ifndef REPSYNC
#define REPSYNC 0
#endif
#ifndef REPPRO
#define REPPRO 0
#endif
constexpr int PT_OFF = 131072 + 4096, MISC_OFF = 131072 + 8192;
__device__ __forceinline__ unsigned char* rd_ptr(int i) {
    const unsigned long long v = *(const LAS unsigned long long*)(((LAS unsigned char*)0) + PT_OFF + 8 * i);
    const unsigned lo = __builtin_amdgcn_readfirstlane((unsigned)v), hi = __builtin_amdgcn_readfirstlane((unsigned)(v >> 32));
    typedef __attribute__((address_space(1))) unsigned char gbyte;
    gbyte* gp = (gbyte*)(((unsigned long long)hi << 32) | lo);
    return (unsigned char*)gp;
}
__device__ __forceinline__ unsigned char* rd_ptr_generic(int i) {
    const unsigned long long v = *(const LAS unsigned long long*)(((LAS unsigned char*)0) + PT_OFF + 8 * i);
    const unsigned lo = __builtin_amdgcn_readfirstlane((unsigned)v), hi = __builtin_amdgcn_readfirstlane((unsigned)(v >> 32));
    return (unsigned char*)(((unsigned long long)hi << 32) | lo);
}
#define P_IN(i) ((const float*)rd_ptr(i))
#define P_OUT() ((float*)rd_ptr(23))
#define P_WS() (rd_ptr(24))

__global__ void __launch_bounds__(NTHR, 2) trunk_fwd(Args args) {
    extern __shared__ __attribute__((aligned(16))) unsigned char lds_raw[];
    cg::grid_group grid = cg::this_grid();
    LAS unsigned char* lds = (LAS unsigned char*)lds_raw;
    {
        const int tid = threadIdx.x;
        LAS unsigned long long* PT = (LAS unsigned long long*)(lds + PT_OFF);
        if (tid < 23) PT[tid] = (unsigned long long)args.in[tid];
        if (tid == 23) PT[23] = (unsigned long long)args.out;
        if (tid == 24) PT[24] = (unsigned long long)args.ws;
        if (tid < 16) ((LAS unsigned*)(lds + MISC_OFF))[tid] = 0u;
        __syncthreads();
        (void)xcd_barrier_post((unsigned*)(args.ws + WS_BAR), (volatile LAS unsigned*)(lds + MISC_OFF));
        const int lane = tid & 63, wave = __builtin_amdgcn_readfirstlane(tid >> 6);
        for (int rp_ = 0; rp_ < (REPPRO ? 2 : 1); ++rp_)
        if (!SKP) prologue(args, args.ws, lds, (int)blockIdx.x * NWAVES + wave, (int)gridDim.x * NWAVES, wave, lane);
    }
    grid.sync();

    constexpr int NREP = (REPMASK || REPSYNC) ? 2 : 1;
    for (int it_ = 0; it_ < 32 * NREP; ++it_) {
        const int st = it_ / NREP, rep_ = it_ % NREP;
        const int l = st >> 4, s = st & 15;
        int kind, hb = 0;
        if (s == 0 || s == 14) kind = 0; else if (s == 1 || s == 15) kind = 1; else { hb = (s - 2) / 6; kind = 2 + (s - 2) % 6; if (kind == 7) kind = 1; }
        const size_t hrow = (size_t)hb * MH;
        int G = gridDim.x, bx = blockIdx.x; asm volatile("" : "+s"(G), "+s"(bx));
        unsigned char* ws = P_WS();
        unsigned char* wl = ws + WS_W + (size_t)l * W_LSTRIDE;
        if (rep_ == 1 && !(((REPMASK >> kind) & 1) || REPSYNC)) continue;
        if (rep_ == 1 && kind == 1 && REPK1SEL && ((REPK1SEL == 1) != (s == 1 || s == 15))) continue;
        if (!(rep_ == 1 && REPSYNC)) {
        if (kind == 0 && !SK0) {
            pg8::Gemm g{(const u16*)(ws + WS_XB), (const u16*)(wl + (s == 0 ? WO_13A : WO_13B)), MROWS, 2 * FF, DM}; pg8::StaticOrder S; S.init(MROWS, 2 * FF, G, bx);
            pg8::EpiSwiglu E{(u16*)(ws + WS_ZA), (const float*)(ws + WS_SSP)};
            pg8::gemm_phase<pg8::EpiSwiglu, pg8::StaticOrder, PG8_ALIGN, PG8_SP2>(lds, g, S, E);
        } else if (kind == 1 && !SK1) {
            const bool ffn = (s == 1 || s == 15);
            const u16* Aop = (const u16*)(ws + (ffn ? WS_ZA : WS_MG)); const u16* Bop = (const u16*)(wl + (s == 1 ? WO_2A : (s == 15 ? WO_2B : WO_OUT)));
            const int Mr = ffn ? MROWS : MH, K = ffn ? FF : DM;
            const float* x0 = nullptr;
            pg8::Gemm g{Aop, Bop, Mr, DM, K}; pg8::StaticOrder S; S.init(Mr, DM, G, bx);
            pg8::EpiResid E{x0, (u16*)(ws + WS_XB) + hrow * DM, (float*)(ws + WS_SSP) + hrow * 16, rep_ ? 0.0f : (ffn ? 0.5f : 1.0f)};
            pg8::gemm_phase<pg8::EpiResid, pg8::StaticOrder, PG8_ALIGN, PG8_SP2>(lds, g, S, E);
        } else if (kind == 2 && !SK2) {
            pg8::Gemm g{(const u16*)(ws + WS_XB) + hrow * DM, (const u16*)(wl + WO_IN), MH, 24 * 256, DM}; pg8::StaticOrder S; S.init(MH, 24 * 256, G, bx);
            pg8::EpiWin E{(u16*)(ws + WS_ZA), (u16*)(ws + WS_QC), (u16*)(ws + WS_KC), (u16*)(ws + WS_VC), (float*)(ws + WS_MIF), (const float*)(ws + WS_SSP) + hrow * 16, (const float*)(ws + WS_COS) + hrow * 32, (const float*)(ws + WS_SIN) + hrow * 32, P_IN(11) + l * 8};
            pg8::gemm_phase<pg8::EpiWin, pg8::StaticOrder, PG8_ALIGN, PG8_SP2>(lds, g, S, E);
        } else if (kind == 3 && !SK3) {
            int tid = threadIdx.x; asm volatile("" : "+v"(tid));
            stage_conv_weights(P_IN(9) + l * 4 * 512, P_IN(10) + l * 512, lds, tid);
            { const u16* Zp = (const u16*)(ws + WS_ZA); const float* mifp = (const float*)(ws + WS_MIF);
              if (bx < 1024) { M1In cur = m1_load(Zp, mifp, bx, tid);
                for (int un = bx; un < 1024; un += G) { const M1In nxt = m1_load(Zp, mifp, un + G < 1024 ? un + G : un, tid);
                    m1_compute(cur, (float*)(ws + WS_U), (float*)(ws + WS_NU), (float*)(ws + WS_ML), (float*)(ws + WS_BL), lds, un, tid);
                    cur = nxt; } } }
            { const u16* Zp = (const u16*)(ws + WS_ZA); const float* pw = P_IN(7) + l * 4 * 4096; const float* psc = P_IN(8) + l * 256;
              if (bx < 1024) { PoolIn cur = pool_load(Zp, pw, bx, tid);
                for (int un = bx; un < 1024; un += G) { const PoolIn nxt = pool_load(Zp, pw, un + G < 1024 ? un + G : un, tid);
                    pool_compute(cur, (u16*)(ws + WS_YA), psc, lds, un, tid);
                    cur = nxt; } } }
        } else if (kind == 4 && !SK4) {
            { int tid = threadIdx.x; asm volatile("" : "+v"(tid));
              m2_phase((const float*)(ws + WS_U), (const float*)(ws + WS_NU), (const float*)(ws + WS_ML), (const float*)(ws + WS_BL), (u16*)(ws + WS_CST), (float*)(ws + WS_NST), (float*)(ws + WS_MST), lds, G, bx, tid); }
            unsigned char* wsg = rd_ptr_generic(24);
            const int rounds = (512 + G - 1) / G;
            for (int r = 0; r < rounds; ++r) {
                const int p = (r & 1) ? (G - 1 - bx) : bx; const int u = r * G + p;
                if (u < 512) { const int qb = 15 - (u >> 5), pair = u & 31, bl = pair >> 3, j = pair & 7;
                    attn_body::attn_unit<8>(qb, (const attn_body::bf16*)((const u16*)(wsg + WS_QC) + (size_t)(bl * 8 + j) * SEQ * 64), (const attn_body::bf16*)((const u16*)(wsg + WS_KC) + (size_t)(bl * 8 + j) * SEQ * 64),
                                            (const attn_body::bf16*)((const u16*)(wsg + WS_VC) + (size_t)((bl * 4 + (j >> 1)) * 2) * SEQ * 64),
                                            (attn_body::bf16*)((u16*)(wsg + WS_O) + (size_t)(bl * SEQ) * 1024 + j * 128), (char*)lds_raw); }
            }
        } else if (kind == 5 && !SK5) {
            int tid = threadIdx.x; asm volatile("" : "+v"(tid));
            stage_conv_weights(P_IN(9) + l * 4 * 512, P_IN(10) + l * 512, lds, tid);
            { const u16* Zp = (const u16*)(ws + WS_ZA); const float* mifp = (const float*)(ws + WS_MIF); const u16* cstp = (const u16*)(ws + WS_CST); const float* nstp = (const float*)(ws + WS_NST); const float* mstp = (const float*)(ws + WS_MST);
              if (bx < 1024) { M3In cur = m3_load(Zp, mifp, cstp, nstp, mstp, bx, tid);
                for (int un = bx; un < 1024; un += G) { const M3In nxt = m3_load(Zp, mifp, cstp, nstp, mstp, un + G < 1024 ? un + G : un, tid);
                    m3_compute(cur, P_IN(12) + l * 256, (u16*)(ws + WS_YB), lds, un, tid);
                    cur = nxt; } } }
            const float lambda_init = 0.8f - 0.6f * expf(-0.3f * (float)l);
            attn_post((const u16*)(ws + WS_O), (u16*)(ws + WS_YC), P_IN(13) + l * 256, P_IN(14) + l * 128, lambda_init, bx * NTHR + tid, G * NTHR, tid & 63);
        } else if (!SK6) {
            pg8::Gemm g{(const u16*)(ws + WS_YA), (const u16*)(wl + WO_PA), 4 * MH, 4 * DM, 256}; pg8::MergeOrder S; S.init(MH, DM, G, bx);
            pg8::EpiMerge E{(const u16*)(ws + WS_ZA), (u16*)(ws + WS_MG)};
            pg8::gemm_phase<pg8::EpiMerge, pg8::MergeOrder, PG8_ALIGN, PG8_SP2>(lds, g, S, E);
        }
        }
        { XcdBarrier bar; bar.bar = (unsigned*)(P_WS() + WS_BAR); bar.x = xb_xcc_id(); bar.st = (volatile LAS unsigned*)(lds + MISC_OFF); xcd_barrier(bar); }
    }
    { const float* fg = P_IN(22); float* outp = P_OUT(); const u16* xb = (const u16*)(P_WS() + WS_XB);
      int tid = threadIdx.x; asm volatile("" : "+v"(tid)); const int lane = tid & 63, gw = (int)blockIdx.x * NWAVES + (tid >> 6), NGW = (int)gridDim.x * NWAVES;
      v4f gg[4];
#pragma unroll
      for (int j = 0; j < 4; ++j) gg[j] = *((const v4f*)(fg + 16 * lane) + j);
      for (int row0 = gw; row0 < MROWS; row0 += 8 * NGW) {
        v4u ra[8], rb[8];
#pragma unroll
        for (int k = 0; k < 8; ++k) { const int row = row0 + k * NGW < MROWS ? row0 + k * NGW : row0; const u16* xr = xb + tl(row, 16 * lane, DM); ra[k] = *(const v4u*)xr; rb[k] = *(const v4u*)(xr + 8); }
        asm volatile("" ::: "memory");
#pragma unroll
        for (int k = 0; k < 8; ++k) { const int row = row0 + k * NGW; if (row < MROWS) { float x[16]; float sq = 0.f;
            unpack8(ra[k], x); unpack8(rb[k], x + 8);
#pragma unroll
            for (int i = 0; i < 16; ++i) sq += x[i] * x[i];
            const float rs = rsqrtf(wave_sum(sq, lane) * (1.0f / DM) + EPS);
            v4f* op = (v4f*)(outp + (size_t)row * DM + 16 * lane);
#pragma unroll
            for (int j = 0; j < 4; ++j) op[j] = (v4f){x[4 * j] * rs * gg[j].x, x[4 * j + 1] * rs * gg[j].y, x[4 * j + 2] * rs * gg[j].z, x[4 * j + 3] * rs * gg[j].w}; } }
      } }
}

extern "C" void kernel_launch(void* const* d_in, const int* in_sizes, int n_in, void* d_out, int out_size, void* d_ws, size_t ws_size, hipStream_t stream) {
    static int grid = 0;
    if (grid == 0) {
        if (n_in != 23 || in_sizes[0] != MROWS * DM || out_size != MROWS * DM || ws_size < WS_END) { fprintf(stderr, "kernel_launch: unexpected shapes / workspace (n_in %d, ws %zu)\n", n_in, ws_size); grid = -1; return; }
        int dev = 0, cus = 0, per_cu = 0;
        hipGetDevice(&dev); hipDeviceGetAttribute(&cus, hipDeviceAttributeMultiprocessorCount, dev);
        hipFuncSetAttribute((const void*)trunk_fwd, hipFuncAttributeMaxDynamicSharedMemorySize, LDS_BYTES);
        hipOccupancyMaxActiveBlocksPerMultiprocessor(&per_cu, (const void*)trunk_fwd, NTHR, LDS_BYTES);
        (void)hipGetLastError();
        if (per_cu < 1) per_cu = 1;
        grid = cus * 1;
        if (grid <= 0) grid = 256;
    }
    if (grid < 0) return;
    if (hipMemsetAsync((char*)d_ws + WS_BAR, 0, CTL_ZERO_BYTES, stream) != hipSuccess) { fprintf(stderr, "kernel_launch: hipMemsetAsync failed\n"); return; }
    Args a{};
    for (int i = 0; i < 23; ++i) a.in[i] = d_in[i];
    a.out = (float*)d_out; a.ws = (unsigned char*)d_ws;
    void* kargs[] = {&a};
    hipError_t e = hipLaunchCooperativeKernel((const void*)trunk_fwd, dim3(grid), dim3(NTHR), kargs, LDS_BYTES, stream);
    if (e != hipSuccess) fprintf(stderr, "cooperative launch failed: %s (grid %d)\n", hipGetErrorString(e), grid);
}
```

```cpp
#include <hip/hip_runtime.h>
#include <cstdio>
#include <cstdint>
namespace pg8 {
#define PG8_LAS __attribute__((address_space(3)))
typedef unsigned short bf16_t;
typedef short bf16x8 __attribute__((ext_vector_type(8)));
typedef float f32x4 __attribute__((ext_vector_type(4)));
typedef unsigned u32x4 __attribute__((ext_vector_type(4)));
constexpr int BM = 256, BK = 64, HALF = 128, HTB = HALF * BK * 2  , STAGE_BYTES = 8 * HTB, NXCD = 8, WGM = 8;

__host__ __device__ __forceinline__ int lds_byte(int r, int c) { const int st = (r >> 4) * 2 + (c >> 5), rr = r & 15, cc = c & 31, ob = rr * 64 + cc * 2; return st * 1024 + (ob ^ (((ob >> 9) & 1) << 5)); }
__host__ __device__ __forceinline__ void stage_rc(int b, int& R, int& C) { const int st = b / 1024, sb = b % 1024, swz = sb ^ (((sb >> 9) & 1) << 5); R = (st >> 1) * 16 + swz / 64; C = (st & 1) * 32 + (swz % 64) / 2; }
__host__ __device__ __forceinline__ int perm32(int rho) { const int n = rho >> 4, i = rho & 15; return 8 * (i >> 2) + 4 * n + (i & 3); }

struct Unit { int pm, pn; };
struct Gemm { const bf16_t* A; const bf16_t* Bt; int M, N, K; };

struct StaticOrder {
    int nM, nN, nwg, G, c;
    __host__ __device__ void init(int M, int N, int G_, int c_) { nM = M / BM; nN = N / BM; nwg = nM * nN; G = G_; c = c_; }
    __host__ __device__ bool next(int i, Unit& u) const {
        const long L = (long)i * G + c; if (L >= nwg) return false;
        int wgid = (int)L; { const int q = nwg / NXCD, r = nwg % NXCD, xcd = wgid % NXCD, off = wgid / NXCD; wgid = (xcd < r ? xcd * (q + 1) : r * (q + 1) + (xcd - r) * q) + off; }
        const int nig = WGM * nN, gid = wgid / nig, fm = gid * WGM, gsz = (nM - fm) < WGM ? (nM - fm) : WGM;
        u.pm = fm + ((wgid % nig) % gsz); u.pn = (wgid % nig) / gsz; return true;
    }
    __device__ __forceinline__ void a_ready(const Unit&) const {}
    __device__ __forceinline__ void done(const Unit&) const {}
};

__device__ __forceinline__ unsigned cvt_pk_bf16(float lo, float hi) { unsigned r; asm volatile("v_cvt_pk_bf16_f32 %0, %1, %2" : "=v"(r) : "v"(lo), "v"(hi)); return r; }
typedef float f32x2 __attribute__((ext_vector_type(2)));
__device__ __forceinline__ f32x2 gelu_pk(f32x2 v) {
    const f32x2 av = __builtin_elementwise_abs(v), d = av * 0.2316418882f + 1.0f;
    f32x2 t; t.x = __builtin_amdgcn_rcpf(d.x); t.y = __builtin_amdgcn_rcpf(d.y);
    f32x2 q = t * 0.5307027145f + (-0.7265760135f); q = q * t + 0.7107068705f; q = q * t + (-0.142248368f); q = q * t + 0.127414796f; q = q * t;
    const f32x2 s = (v * v) * (-0.72134752044f);
    f32x2 e; e.x = __builtin_amdgcn_exp2f(s.x); e.y = __builtin_amdgcn_exp2f(s.y);
    const f32x2 m = v * (q * e), r = v - m;
    f32x2 o; o.x = v.x < 0.f ? m.x : r.x; o.y = v.y < 0.f ? m.y : r.y; return o;
}

template <int ACT  > struct EpiBf16 {
    static constexpr bool PERM = true, AFTER_DRAIN = false; static_assert(ACT == 0 || ACT == 1, "EpiBf16: ACT is 0 (none) or 1 (gelu_pk)");
    bf16_t* O; int ldc; const float* bias; int split_cols; size_t split_stride; float scale0;
    __device__ __forceinline__ void operator()(const f32x4 (&acc)[2][2][4][2], const Unit& u, int wr, int wc, int fr, int fq) const {
        const int row0 = u.pm * BM + wr * 64 + fr; int colt = u.pn * BM; bf16_t* base = O;
        float sc = 1.f; if (split_cols) { const int t = colt / split_cols; base += (size_t)t * split_stride; colt -= t * split_cols; if (t == 0) sc = scale0; }
        const int col0 = colt + wc * 32 + 8 * fq, bcol0 = u.pn * BM + wc * 32 + 8 * fq;
        f32x4 bv[2][2];
#pragma unroll
        for (int bj = 0; bj < 2; ++bj)
#pragma unroll
            for (int n = 0; n < 2; ++n) bv[bj][n] = bias ? *(const f32x4*)(bias + bcol0 + bj * HALF + 4 * n) : (f32x4){0.f, 0.f, 0.f, 0.f};
#pragma unroll
        for (int ai = 0; ai < 2; ++ai)
#pragma unroll
            for (int m = 0; m < 4; ++m) { bf16_t* rowp = base + (size_t)(row0 + ai * HALF + m * 16) * ldc + col0;
#pragma unroll
                for (int bj = 0; bj < 2; ++bj) { f32x4 v0 = acc[ai][bj][m][0] + bv[bj][0], v1 = acc[ai][bj][m][1] + bv[bj][1];
                    if (ACT == 1) { f32x2 a = gelu_pk((f32x2){v0[0], v0[1]}), b = gelu_pk((f32x2){v0[2], v0[3]}), c = gelu_pk((f32x2){v1[0], v1[1]}), d = gelu_pk((f32x2){v1[2], v1[3]});
                        v0 = (f32x4){a.x, a.y, b.x, b.y}; v1 = (f32x4){c.x, c.y, d.x, d.y}; }
                    v0 = v0 * sc; v1 = v1 * sc; u32x4 w; w.x = cvt_pk_bf16(v0[0], v0[1]); w.y = cvt_pk_bf16(v0[2], v0[3]); w.z = cvt_pk_bf16(v1[0], v1[1]); w.w = cvt_pk_bf16(v1[2], v1[3]);
                    *(u32x4*)(rowp + bj * HALF) = w; } }
    }
};

template <class Epi, class Sched, bool ALIGN_EPI = false, bool SP2 = false>
__device__ __forceinline__ void gemm_phase(PG8_LAS unsigned char* lds, const Gemm g, const Sched& S, const Epi& E) {
    int tid = threadIdx.x; asm volatile("" : "+v"(tid));
    const int wid = __builtin_amdgcn_readfirstlane(tid >> 6), lane = tid & 63, wr = wid >> 2, wc = wid & 3, fr = lane & 15, fq = lane >> 4;
    const int K = g.K, nt = K / BK;
    unsigned voffA[2], voffB[2];
#pragma unroll
    for (int i = 0; i < 2; ++i) { int R, C; stage_rc(tid * 16 + i * 8192, R, C); const int Rb = Epi::PERM ? ((R & ~31) + perm32(R & 31)) : R;
        voffA[i] = (unsigned)(R * BK + C) * 2u; voffB[i] = (unsigned)(Rb * BK + C) * 2u; }
    const size_t kstep = (size_t)(BM * BK * 2);
    const size_t hstep = (size_t)HALF * BK * 2;
    const size_t tstep = (size_t)BM * K * 2;
    const unsigned ldsw = (unsigned)wid * 1024u;
    const int aoff = lds_byte(wr * 64 + fr, fq * 8), boff = lds_byte(wc * 32 + fr, fq * 8);
#define PG8_SA(b, h) (((b) * 2 + (h)) * HTB)
#define PG8_SB(b, h) ((4 + (b) * 2 + (h)) * HTB)
#define PG8_STAGE(bufoff, gbase, voff) do { _Pragma("unroll") for (int _i = 0; _i < 2; ++_i) \
        __builtin_amdgcn_global_load_lds((const unsigned*)((const char*)(gbase) + (voff)[_i]), (PG8_LAS unsigned*)(lds + (bufoff) + ldsw + _i * 8192), 16, 0, 0); } while (0)
#define PG8_LDA(dst, b, h) do { _Pragma("unroll") for (int m = 0; m < 4; ++m) _Pragma("unroll") for (int k = 0; k < 2; ++k) dst[m][k] = *(const PG8_LAS bf16x8*)(lds + PG8_SA(b, h) + aoff + m * 2048 + k * 1024); } while (0)
#define PG8_LDB(dst, b, h) do { _Pragma("unroll") for (int n = 0; n < 2; ++n) _Pragma("unroll") for (int k = 0; k < 2; ++k) dst[n][k] = *(const PG8_LAS bf16x8*)(lds + PG8_SB(b, h) + boff + n * 2048 + k * 1024); } while (0)
#define PG8_MMA(ai, bj, At, Bt) do { __builtin_amdgcn_s_setprio(1); _Pragma("unroll") for (int m = 0; m < 4; ++m) _Pragma("unroll") for (int n = 0; n < 2; ++n) _Pragma("unroll") for (int k = 0; k < 2; ++k) \
        acc[ai][bj][m][n] = __builtin_amdgcn_mfma_f32_16x16x32_bf16(Bt[n][k], At[m][k], acc[ai][bj][m][n], 0, 0, 0); __builtin_amdgcn_s_setprio(0); } while (0)
#define PG8_WAIT_V(n) asm volatile("s_waitcnt vmcnt(" #n ")" ::: "memory")
#define PG8_WAIT_L(n) asm volatile("s_waitcnt lgkmcnt(" #n ")" ::: "memory")
#define PG8_BAR __builtin_amdgcn_s_barrier()
#define PG8_SCHED __builtin_amdgcn_sched_barrier(0)
    Unit cur, nxt; int ui = 0;
    if (!S.next(0, cur)) return;
    f32x4 acc[2][2][4][2];
#pragma unroll
    for (int a = 0; a < 2; ++a)
#pragma unroll
        for (int b = 0; b < 2; ++b)
#pragma unroll
            for (int m = 0; m < 4; ++m)
#pragma unroll
                for (int n = 0; n < 2; ++n) acc[a][b][m][n] = (f32x4){0.f, 0.f, 0.f, 0.f};
    bf16x8 At[4][2], B0[2][2], B1[2][2];
    const char* cA = (const char*)g.A + (size_t)cur.pm * tstep; const char* cB = (const char*)g.Bt + (size_t)cur.pn * tstep;
    S.a_ready(cur);
    if constexpr (SP2) {
        PG8_STAGE(PG8_SB(0, 0), cB, voffB); PG8_STAGE(PG8_SB(0, 1), cB + hstep, voffB); PG8_STAGE(PG8_SA(0, 0), cA, voffA); PG8_STAGE(PG8_SA(0, 1), cA + hstep, voffA);
        if (wr == 1) PG8_BAR;
        PG8_WAIT_V(2); PG8_BAR;
        PG8_STAGE(PG8_SB(1, 0), cB + kstep, voffB); PG8_STAGE(PG8_SA(1, 0), cA + kstep, voffA); PG8_STAGE(PG8_SB(1, 1), cB + hstep + kstep, voffB);
        PG8_WAIT_V(6); PG8_BAR;
    } else {
        PG8_STAGE(PG8_SB(0, 0), cB, voffB); PG8_STAGE(PG8_SA(0, 0), cA, voffA); PG8_STAGE(PG8_SB(0, 1), cB + hstep, voffB); PG8_STAGE(PG8_SA(0, 1), cA + hstep, voffA);
        if (wr == 1) PG8_BAR;
        PG8_WAIT_V(4); PG8_BAR;
        PG8_STAGE(PG8_SB(1, 0), cB + kstep, voffB); PG8_STAGE(PG8_SA(1, 0), cA + kstep, voffA); PG8_STAGE(PG8_SB(1, 1), cB + hstep + kstep, voffB);
        PG8_WAIT_V(6); PG8_BAR;
    }
    for (;;) {
        const bool has_next = S.next(ui + 1, nxt);
        const char* nA = has_next ? (const char*)g.A + (size_t)nxt.pm * tstep : cA; const char* nB = has_next ? (const char*)g.Bt + (size_t)nxt.pn * tstep : cB;
        for (int t = 0; t < nt; t += 2) {
            const bool last = (t == nt - 2);
            const char* a1 = cA + (size_t)(t + 1) * kstep;
            const char* a2 = last ? nA : cA + (size_t)(t + 2) * kstep; const char* b2 = last ? nB : cB + (size_t)(t + 2) * kstep;
            const char* a3 = a2 + kstep; const char* b3 = b2 + kstep;
            if (last && has_next) S.a_ready(nxt);
            if constexpr (SP2) {
            PG8_LDB(B0, 0, 0); PG8_LDB(B1, 0, 1); PG8_SCHED; PG8_LDA(At, 0, 0); PG8_STAGE(PG8_SA(1, 1), a1 + hstep, voffA);
            PG8_WAIT_V(8); PG8_WAIT_L(0); PG8_BAR; PG8_MMA(0, 0, At, B0); PG8_MMA(0, 1, At, B1); PG8_BAR; PG8_SCHED;
            PG8_LDA(At, 0, 1); PG8_STAGE(PG8_SB(0, 0), b2, voffB); PG8_STAGE(PG8_SB(0, 1), b2 + hstep, voffB); PG8_STAGE(PG8_SA(0, 0), a2, voffA);
            PG8_WAIT_V(8); PG8_WAIT_L(0); PG8_BAR; PG8_MMA(1, 0, At, B0); PG8_MMA(1, 1, At, B1); PG8_BAR; PG8_SCHED;
            PG8_LDB(B0, 1, 0); PG8_LDB(B1, 1, 1); PG8_SCHED; PG8_LDA(At, 1, 0); PG8_STAGE(PG8_SA(0, 1), a2 + hstep, voffA);
            PG8_WAIT_V(8); PG8_WAIT_L(0); PG8_BAR; PG8_MMA(0, 0, At, B0); PG8_MMA(0, 1, At, B1); PG8_BAR; PG8_SCHED;
            PG8_LDA(At, 1, 1); PG8_STAGE(PG8_SB(1, 0), b3, voffB); PG8_STAGE(PG8_SB(1, 1), b3 + hstep, voffB); PG8_STAGE(PG8_SA(1, 0), a3, voffA);
            PG8_WAIT_V(8); PG8_WAIT_L(0); PG8_BAR; PG8_MMA(1, 0, At, B0); PG8_MMA(1, 1, At, B1); PG8_BAR; PG8_SCHED;
            } else {
            PG8_LDB(B0, 0, 0); PG8_SCHED; PG8_LDA(At, 0, 0); PG8_STAGE(PG8_SA(1, 1), a1 + hstep, voffA);
            PG8_WAIT_L(8); PG8_BAR; PG8_WAIT_L(0); PG8_MMA(0, 0, At, B0); PG8_BAR; PG8_SCHED;
            PG8_LDB(B1, 0, 1); PG8_STAGE(PG8_SB(0, 0), b2, voffB);
            PG8_BAR; PG8_WAIT_L(0); PG8_MMA(0, 1, At, B1); PG8_BAR;
            PG8_LDA(At, 0, 1); PG8_STAGE(PG8_SA(0, 0), a2, voffA);
            PG8_BAR; PG8_WAIT_L(0); PG8_MMA(1, 0, At, B0); PG8_BAR; PG8_SCHED;
            PG8_STAGE(PG8_SB(0, 1), b2 + hstep, voffB);
            PG8_WAIT_V(6); PG8_BAR; PG8_MMA(1, 1, At, B1); PG8_BAR;
            PG8_LDB(B0, 1, 0); PG8_SCHED; PG8_LDA(At, 1, 0); PG8_STAGE(PG8_SA(0, 1), a2 + hstep, voffA);
            PG8_WAIT_L(8); PG8_BAR; PG8_WAIT_L(0); PG8_MMA(0, 0, At, B0); PG8_BAR; PG8_SCHED;
            PG8_LDB(B1, 1, 1); PG8_STAGE(PG8_SB(1, 0), b3, voffB);
            PG8_BAR; PG8_WAIT_L(0); PG8_MMA(0, 1, At, B1); PG8_BAR;
            PG8_LDA(At, 1, 1); PG8_STAGE(PG8_SA(1, 0), a3, voffA);
            PG8_BAR; PG8_WAIT_L(0); PG8_MMA(1, 0, At, B0); PG8_BAR; PG8_SCHED;
            PG8_STAGE(PG8_SB(1, 1), b3 + hstep, voffB);
            PG8_WAIT_V(6); PG8_BAR; PG8_MMA(1, 1, At, B1); PG8_BAR;
            }
        }
        if constexpr (ALIGN_EPI) { if (wr == 0) PG8_BAR; }
        const bool keep = Epi::keep_acc(cur);
        if constexpr (!Epi::AFTER_DRAIN) { if (!keep) E(acc, cur, wr, wc, fr, fq); S.done(cur); }
        if (!has_next) break;
        if (!keep)
#pragma unroll
        for (int a = 0; a < 2; ++a)
#pragma unroll
            for (int b = 0; b < 2; ++b)
#pragma unroll
                for (int m = 0; m < 4; ++m)
#pragma unroll
                    for (int n = 0; n < 2; ++n) acc[a][b][m][n] = (f32x4){0.f, 0.f, 0.f, 0.f};
        cur = nxt; cA = nA; cB = nB; ++ui;
        if constexpr (ALIGN_EPI) { if (wr == 1) PG8_BAR; }
    }
    PG8_WAIT_V(0);
    if constexpr (!ALIGN_EPI) { if (wr == 0) PG8_BAR; }
    PG8_BAR;
    if constexpr (Epi::AFTER_DRAIN) { E.fused(acc, cur, wr, wc, fr, fq, lds, wid, lane); S.done(cur); }
#undef PG8_SA
#undef PG8_SB
#undef PG8_STAGE
#undef PG8_LDA
#undef PG8_LDB
#undef PG8_MMA
#undef PG8_WAIT_V
#undef PG8_WAIT_L
#undef PG8_BAR
#undef PG8_SCHED
}
}

#ifndef PG8_SP2
#define PG8_SP2 true
#endif
#ifndef PG8_ALIGN
#define PG8_ALIGN true
#endif
#include <hip/hip_bf16.h>
#include <cmath>
namespace attn_body {
using bf16=__hip_bfloat16;
using bf16x8=__attribute__((ext_vector_type(8)))short;
using s16x4=__attribute__((ext_vector_type(4)))short;
using f32x16=__attribute__((ext_vector_type(16)))float;
using u32x4=__attribute__((ext_vector_type(4)))unsigned;
constexpr int SEQ=4096,D=64,PZ=64,PO=1024;
constexpr int NW=8,QBLK=32,QB=QBLK*NW,KVBLK=64,NQB=SEQ/QB;
constexpr int ATTN_UNIT_ROWS=QB;
__device__ __forceinline__ int crow(int r,int hi){return (r&3)+8*(r>>2)+4*hi;}
#define SBAR() __builtin_amdgcn_sched_barrier(0)
__device__ __forceinline__ void cmask(f32x16&p0,f32x16&p1,int jb,int qrel,int hi){
  const float NEG=-INFINITY; int kb=64*jb+4*hi;
  #pragma unroll
  for(int r=0;r<16;++r){int kv=kb+(r&3)+8*(r>>2); if(kv>qrel)p0[r]=NEG; if(kv+32>qrel)p1[r]=NEG;}
}

constexpr int NSLOT=3, SLOTB=8192;
constexpr int LDS_K=0, LDS_V=NSLOT*SLOTB, LDS_V2=2*NSLOT*SLOTB  , LDS_WS=3*NSLOT*SLOTB, LDS_OST=LDS_WS+NW*64*4, LDS_BYTES=LDS_OST+NW*4096;
constexpr float C2=0.125f*1.4426950408889634f;
__device__ __forceinline__ void glds16(const void*gsrc,unsigned lds_dst){unsigned keep;
  asm volatile("s_mov_b32 %0, m0\n\ts_mov_b32 m0, %2\n\ts_nop 0\n\tglobal_load_lds_dwordx4 %1, off\n\ts_mov_b32 m0, %0":"=&s"(keep):"v"(gsrc),"s"(lds_dst):"memory");}
__device__ __forceinline__ float max3f(float a,float b,float c){float r;asm("v_max3_f32 %0, %1, %2, %3":"=v"(r):"v"(a),"v"(b),"v"(c));return r;}
__device__ __forceinline__ float max2f(float a,float b){float r;asm("v_max_f32_e32 %0, %1, %2":"=v"(r):"v"(a),"v"(b));return r;}
__device__ __forceinline__ float fadd_s(float a,float b){float r;asm("v_add_f32_e32 %0, %1, %2":"=v"(r):"v"(a),"v"(b));return r;}
__device__ __forceinline__ float fsub_s(float a,float b){float r;asm("v_sub_f32_e32 %0, %1, %2":"=v"(r):"v"(a),"v"(b));return r;}
typedef float f32x2_t __attribute__((ext_vector_type(2))); typedef __bf16 bf16x2_t __attribute__((ext_vector_type(2)));
__device__ __forceinline__ unsigned cvtpk_s(float lo,float hi){f32x2_t v={lo,hi};bf16x2_t b=__builtin_convertvector(v,bf16x2_t);return __builtin_bit_cast(unsigned,b);}
#define WAIT_BAR(N) asm volatile("s_waitcnt vmcnt(" #N ") lgkmcnt(0)\n\ts_barrier":::"memory")

__device__ __forceinline__ void qkt(f32x16&p0,f32x16&p1,const char*Kslot,const bf16x8*qr,const f32x16&negm,int r32,int hi){
  const char*kb=Kslot+hi*1024+r32*16;
  #pragma unroll
  for(int d0=0;d0<4;++d0){
    const bf16x8 b0=*reinterpret_cast<const bf16x8*>(kb+d0*2048);
    const bf16x8 b1=*reinterpret_cast<const bf16x8*>(kb+d0*2048+512);
    if(d0==0){p0=__builtin_amdgcn_mfma_f32_32x32x16_bf16(b0,qr[0],negm,0,0,0);p1=__builtin_amdgcn_mfma_f32_32x32x16_bf16(b1,qr[0],negm,0,0,0);}
    else{p0=__builtin_amdgcn_mfma_f32_32x32x16_bf16(b0,qr[d0],p0,0,0,0);p1=__builtin_amdgcn_mfma_f32_32x32x16_bf16(b1,qr[d0],p1,0,0,0);}}
}
typedef __attribute__((address_space(3))) const char* lds_cptr;
typedef short v4i16_t __attribute__((ext_vector_type(4)));
__device__ __forceinline__ void kload8(bf16x8*kf,lds_cptr kp){
  kf[0]=*(const __attribute__((address_space(3))) bf16x8*)(kp);      kf[1]=*(const __attribute__((address_space(3))) bf16x8*)(kp+512);
  kf[2]=*(const __attribute__((address_space(3))) bf16x8*)(kp+2048); kf[3]=*(const __attribute__((address_space(3))) bf16x8*)(kp+2560);
  kf[4]=*(const __attribute__((address_space(3))) bf16x8*)(kp+4096); kf[5]=*(const __attribute__((address_space(3))) bf16x8*)(kp+4608);
  kf[6]=*(const __attribute__((address_space(3))) bf16x8*)(kp+6144); kf[7]=*(const __attribute__((address_space(3))) bf16x8*)(kp+6656);
}
__device__ __forceinline__ void kload2(bf16x8*kf,lds_cptr kp,int j){ kf[2*j]=*(const __attribute__((address_space(3))) bf16x8*)(kp+j*2048); kf[2*j+1]=*(const __attribute__((address_space(3))) bf16x8*)(kp+j*2048+512); }
__device__ __forceinline__ s16x4 vtr(lds_cptr p){ return __builtin_bit_cast(s16x4,__builtin_amdgcn_ds_read_tr16_b64_v4i16((__attribute__((address_space(3))) v4i16_t*)p)); }
__device__ __forceinline__ float rowmax(const f32x16&p0,const f32x16&p1){
  float a=max3f(p0[0],p0[1],p1[0]),b=max3f(p0[2],p0[3],p1[1]);a=max3f(a,p1[2],p1[3]);
  #pragma unroll
  for(int r=4;r<16;r+=4){a=max3f(a,p0[r],p0[r+1]);b=max3f(b,p0[r+2],p0[r+3]);a=max3f(a,p1[r],p1[r+1]);b=max3f(b,p1[r+2],p1[r+3]);}
  const float m=max2f(a,b);
  auto rr=__builtin_amdgcn_permlane32_swap(__float_as_uint(m),__float_as_uint(m),false,false);
  return max2f(__uint_as_float(rr[0]),__uint_as_float(rr[1]));
}
__device__ __forceinline__ void pv(f32x16*o,int vb,bf16x8 pa0,bf16x8 pa1,bf16x8 pa2,bf16x8 pa3){
  #pragma unroll
  for(int d0=0;d0<2;++d0){s16x4 lo[4],hi[4];
    #pragma unroll
    for(int ks=0;ks<4;++ks){
      asm volatile("ds_read_b64_tr_b16 %0,%1 offset:%c2":"=&v"(lo[ks]):"v"(vb),"i"(d0*4096+ks*1024):"memory");
      asm volatile("ds_read_b64_tr_b16 %0,%1 offset:%c2":"=&v"(hi[ks]):"v"(vb),"i"(d0*4096+ks*1024+512):"memory");}
    asm volatile("s_waitcnt lgkmcnt(0)":::"memory");SBAR();
    #define PK(k) (bf16x8){lo[k][0],lo[k][1],lo[k][2],lo[k][3],hi[k][0],hi[k][1],hi[k][2],hi[k][3]}
    o[d0]=__builtin_amdgcn_mfma_f32_32x32x16_bf16(pa0,PK(0),o[d0],0,0,0);
    o[d0]=__builtin_amdgcn_mfma_f32_32x32x16_bf16(pa1,PK(1),o[d0],0,0,0);
    o[d0]=__builtin_amdgcn_mfma_f32_32x32x16_bf16(pa2,PK(2),o[d0],0,0,0);
    o[d0]=__builtin_amdgcn_mfma_f32_32x32x16_bf16(pa3,PK(3),o[d0],0,0,0);
    #undef PK
  }
}

#ifndef ATTN_STORE16
#define ATTN_STORE16(p,v) (*(u32x4*)(p)=(v))
#endif
template<int THRL> __device__ __forceinline__ void attn_unit(int qb,const bf16*Q,const bf16*__restrict__ K,const bf16*__restrict__ V,bf16*O,char*shm){
  int tid=threadIdx.x; asm volatile("":"+v"(tid)); const int lane=tid&63,r32=lane&31,hi=lane>>5; const int wid=__builtin_amdgcn_readfirstlane(tid>>6);
  const int q0=qb*QB;
  const bf16*Qw=Q+(long)(q0+wid*QBLK)*PZ;
  const bf16*Kh=K,*Vh=V;
  const unsigned lds0=(unsigned)(uintptr_t)shm;
  float*wsf=(float*)(shm+LDS_WS)+wid*64;
  const bf16*ksrc=Kh+(long)lane*PZ+wid*8;
  const bf16*vsrc=Vh+(long)(16*(wid&3)+(lane>>2))*PZ+(wid>>2)*32+(lane&3)*8;
  const unsigned kdst=lds0+LDS_K+wid*1024, vdst=lds0+LDS_V+wid*1024;
  #define DMA_K(t,slot) glds16(ksrc+(long)(t)*KVBLK*PZ,(unsigned)__builtin_amdgcn_readfirstlane(kdst+(slot)))
  #define DMA_V(t,slot) do{ glds16(vsrc+(long)(t)*KVBLK*PZ,(unsigned)__builtin_amdgcn_readfirstlane(vdst+(slot))); glds16(vsrc+(long)SEQ*PZ+(long)(t)*KVBLK*PZ,(unsigned)__builtin_amdgcn_readfirstlane(vdst+NSLOT*SLOTB+(slot))); }while(0)
  const int vb0=(int)(lds0+LDS_V)+((lane>>4)&1)*32+(lane&3)*8+(4*hi+((lane&15)>>2))*64;
  const char*Kbase=shm+LDS_K; bf16x8 kf[8];
  const lds_cptr shm3=(lds_cptr)shm; const lds_cptr kp0=shm3+LDS_K+hi*1024+r32*16; const lds_cptr vp0=shm3+LDS_V+((lane>>4)&1)*32+(lane&3)*8+(4*hi+((lane&15)>>2))*64;
  const int NT=(q0+QB)/KVBLK;
  DMA_K(0,0);DMA_V(0,0);DMA_K(1,SLOTB);
  bf16x8 qr[4];
  #pragma unroll
  for(int d0=0;d0<4;++d0)qr[d0]=*reinterpret_cast<const bf16x8*>(&Qw[(long)r32*PZ+d0*16+hi*8]);
  float mhat=0.f,l_reg=0.f;f32x16 o[4];o[0]=f32x16{};o[1]=f32x16{};o[2]=f32x16{};o[3]=f32x16{};f32x16 negm=f32x16{};asm volatile("":"+v"(negm));
  const int qrel=wid*QBLK+r32;
  #define CMASK(P0,P1,t) do{int jb_=(t)-(NT-4); if(jb_>=0)cmask(P0,P1,jb_,qrel,hi);}while(0)
  bool resc=false;
  #define START(P0,P1) do{ const float rm=rowmax(P0,P1); resc=false; \
    { const float dl=rm; mhat=fadd_s(mhat,dl); \
      _Pragma("unroll") for(int r=0;r<16;++r){P0[r]=fsub_s(P0[r],dl);P1[r]=fsub_s(P1[r],dl);} \
      _Pragma("unroll") for(int r=0;r<16;++r)negm[r]=-mhat; asm volatile("":"+v"(negm)); } \
    _Pragma("unroll") for(int r=0;r<16;++r)P0[r]=__builtin_amdgcn_exp2f(P0[r]); }while(0)
  #define RESC() do{ if(resc){ asm volatile("s_waitcnt lgkmcnt(0)":::"memory"); \
      _Pragma("unroll") for(int d_=0;d_<4;++d_) _Pragma("unroll") for(int r=0;r<16;++r)o[d_][r]*=wsf[crow(r,hi)]; } }while(0)
  f32x16 pA0,pA1,pB0,pB1;
  int sl_prev=0,sl_cur=0,sl_next=SLOTB;
  #define ROT() do{sl_prev=sl_cur;sl_cur=sl_next;sl_next=(sl_next==(NSLOT-1)*SLOTB)?0:sl_next+SLOTB;}while(0)
  DMA_K(2,2*SLOTB);
  WAIT_BAR(4);
  qkt(pA0,pA1,Kbase,qr,negm,r32,hi);asm volatile("s_nop 15\n\ts_nop 7":"+v"(pA0),"+v"(pA1));CMASK(pA0,pA1,0);
  START(pA0,pA1);
  _Pragma("unroll") for(int r=0;r<16;++r)pA1[r]=__builtin_amdgcn_exp2f(pA1[r]);
  WAIT_BAR(0);
  DMA_K(3,0);DMA_V(1,SLOTB);
  ROT();
  kload8(kf,kp0+sl_cur);
  WAIT_BAR(3);
  s16x4 vlo[8],vhi[8]; u32x4 pw0,pw1,pw2,pw3;
  #define PKW(P,B) cvtpk_s(P[B],P[B+1])
  #define PAF(k) __builtin_bit_cast(bf16x8,pw##k)
  #define VFR(i) (bf16x8){vlo[i][0],vlo[i][1],vlo[i][2],vlo[i][3],vhi[i][0],vhi[i][1],vhi[i][2],vhi[i][3]}
  #define PIN(x) asm volatile("":"+v"(x))
  #define MX3(a,b,c) __builtin_fmaxf(__builtin_fmaxf((a),(b)),(c))
  #define GAPA(MF,A0,A1,A2,A3,W0,W1,PW) do{ MF; sacc+=A0; sacc+=A1; sacc+=A2; sacc+=A3; PIN(sacc); W0; W1; PIN(PW); SBAR(); }while(0)
  #define EX(v) __builtin_amdgcn_exp2f(v)
  #define GAPB(MF,X,B) do{ MF; X[B]=EX(X[B]); X[B+1]=EX(X[B+1]); X[B+2]=EX(X[B+2]); X[B+3]=EX(X[B+3]); PIN(X); SBAR(); }while(0)
  #define GAPE(MF,X,B) do{ MF; X[B]=EX(X[B]); X[B+1]=EX(X[B+1]); PIN(X); SBAR(); }while(0)
  #define VRD(i) do{ vlo[i]=vtr(vp_+(((i)>>2)*4096+((i)&3)*1024)); vhi[i]=vtr(vp_+(((i)>>2)*4096+((i)&3)*1024+512)); }while(0)
  #define VRD2(i) do{ vlo[i]=vtr(vp_+(NSLOT*SLOTB+((i)>>2)*4096+((i)&3)*1024)); vhi[i]=vtr(vp_+(NSLOT*SLOTB+((i)>>2)*4096+((i)&3)*1024+512)); SBAR(); }while(0)
  #define KRD(G,j) do{ if(G){ kload2(kf,kp0+sl_next,j); SBAR(); } }while(0)
  #define STEP(C0,C1,P0,P1,t,GK,GV,GL) do{ SBAR(); \
    const lds_cptr vp_=vp0+sl_prev; \
    VRD(0); SBAR(); float sacc=(P0[0]+P0[1]); \
    GAPA(C0=__builtin_amdgcn_mfma_f32_32x32x16_bf16(kf[0],qr[0],negm,0,0,0), P0[2],P0[3],P0[4],P0[5],     pw0[0]=PKW(P0,0), pw0[1]=PKW(P0,2), pw0); \
    VRD(4); SBAR(); GAPA(C1=__builtin_amdgcn_mfma_f32_32x32x16_bf16(kf[1],qr[0],negm,0,0,0), P0[6],P0[7],P0[8],P0[9],     pw0[2]=PKW(P0,4), pw0[3]=PKW(P0,6), pw0); \
    VRD(1); SBAR(); GAPA(C0=__builtin_amdgcn_mfma_f32_32x32x16_bf16(kf[2],qr[1],C0,0,0,0),   P0[10],P0[11],P0[12],P0[13], pw1[0]=PKW(P0,8), pw1[1]=PKW(P0,10), pw1); \
    VRD(5); SBAR(); GAPA(C1=__builtin_amdgcn_mfma_f32_32x32x16_bf16(kf[3],qr[1],C1,0,0,0),   P0[14],P0[15],P1[0],P1[1],   pw1[2]=PKW(P0,12),pw1[3]=PKW(P0,14), pw1); \
    VRD(2); SBAR(); GAPA(C0=__builtin_amdgcn_mfma_f32_32x32x16_bf16(kf[4],qr[2],C0,0,0,0),   P1[2],P1[3],P1[4],P1[5],     pw2[0]=PKW(P1,0), pw2[1]=PKW(P1,2), pw2); \
    VRD(6); SBAR(); GAPA(C1=__builtin_amdgcn_mfma_f32_32x32x16_bf16(kf[5],qr[2],C1,0,0,0),   P1[6],P1[7],P1[8],P1[9],     pw2[2]=PKW(P1,4), pw2[3]=PKW(P1,6), pw2); \
    VRD(3); SBAR(); GAPA(C0=__builtin_amdgcn_mfma_f32_32x32x16_bf16(kf[6],qr[3],C0,0,0,0),   P1[10],P1[11],P1[12],P1[13], pw3[0]=PKW(P1,8), pw3[1]=PKW(P1,10), pw3); \
    VRD(7); SBAR(); GAPA(C1=__builtin_amdgcn_mfma_f32_32x32x16_bf16(kf[7],qr[3],C1,0,0,0),   P1[14],P1[15],0.f,0.f,       pw3[2]=PKW(P1,12),pw3[3]=PKW(P1,14), pw3); \
    l_reg+=sacc; \
    if(GK){DMA_K((t)+3,sl_cur);} if(GV){DMA_V((t)+1,sl_next);} \
    CMASK(C0,C1,t); \
    { float a=MX3(C0[0],C0[1],C1[0]),b=MX3(C0[2],C0[3],C1[1]); a=MX3(a,C1[2],C1[3]); \
      _Pragma("unroll") for(int r=4;r<16;r+=4){a=MX3(a,C0[r],C0[r+1]);b=MX3(b,C0[r+2],C0[r+3]);a=MX3(a,C1[r],C1[r+1]);b=MX3(b,C1[r+2],C1[r+3]);} \
      float rm=__builtin_fmaxf(a,b); { auto rr=__builtin_amdgcn_permlane32_swap(__float_as_uint(rm),__float_as_uint(rm),false,false); rm=__builtin_fmaxf(__uint_as_float(rr[0]),__uint_as_float(rr[1])); } \
      resc=false; \
      if(__builtin_expect(__any(rm>(float)THRL),0)){ const float dl=__builtin_fmaxf(rm,0.f); mhat+=dl; \
        _Pragma("unroll") for(int r=0;r<16;++r){C0[r]-=dl;C1[r]-=dl;} \
        _Pragma("unroll") for(int r=0;r<16;++r)negm[r]=-mhat; asm volatile("":"+v"(negm)); \
        const float f=__builtin_amdgcn_exp2f(-dl); l_reg*=f; if(hi==0)wsf[r32]=f; resc=true; } } \
    SBAR(); \
    GAPE(o[0]=__builtin_amdgcn_mfma_f32_32x32x16_bf16(PAF(0),VFR(0),o[0],0,0,0), C0,0); VRD2(0); \
    GAPE(o[1]=__builtin_amdgcn_mfma_f32_32x32x16_bf16(PAF(0),VFR(4),o[1],0,0,0), C0,2); VRD2(4); \
    KRD(GL,0); GAPE(o[0]=__builtin_amdgcn_mfma_f32_32x32x16_bf16(PAF(1),VFR(1),o[0],0,0,0), C0,4); VRD2(1); \
    KRD(GL,1); GAPE(o[1]=__builtin_amdgcn_mfma_f32_32x32x16_bf16(PAF(1),VFR(5),o[1],0,0,0), C0,6); VRD2(5); \
    KRD(GL,2); GAPE(o[0]=__builtin_amdgcn_mfma_f32_32x32x16_bf16(PAF(2),VFR(2),o[0],0,0,0), C0,8); VRD2(2); \
    KRD(GL,3); GAPE(o[1]=__builtin_amdgcn_mfma_f32_32x32x16_bf16(PAF(2),VFR(6),o[1],0,0,0), C0,10); VRD2(6); \
    GAPE(o[0]=__builtin_amdgcn_mfma_f32_32x32x16_bf16(PAF(3),VFR(3),o[0],0,0,0), C0,12); VRD2(3); \
    GAPE(o[1]=__builtin_amdgcn_mfma_f32_32x32x16_bf16(PAF(3),VFR(7),o[1],0,0,0), C0,14); VRD2(7); \
      \
    GAPE(o[2]=__builtin_amdgcn_mfma_f32_32x32x16_bf16(PAF(0),VFR(0),o[2],0,0,0), C1,0); \
    GAPE(o[3]=__builtin_amdgcn_mfma_f32_32x32x16_bf16(PAF(0),VFR(4),o[3],0,0,0), C1,2); \
    GAPE(o[2]=__builtin_amdgcn_mfma_f32_32x32x16_bf16(PAF(1),VFR(1),o[2],0,0,0), C1,4); \
    GAPE(o[3]=__builtin_amdgcn_mfma_f32_32x32x16_bf16(PAF(1),VFR(5),o[3],0,0,0), C1,6); \
    GAPE(o[2]=__builtin_amdgcn_mfma_f32_32x32x16_bf16(PAF(2),VFR(2),o[2],0,0,0), C1,8); \
    GAPE(o[3]=__builtin_amdgcn_mfma_f32_32x32x16_bf16(PAF(2),VFR(6),o[3],0,0,0), C1,10); \
    GAPE(o[2]=__builtin_amdgcn_mfma_f32_32x32x16_bf16(PAF(3),VFR(3),o[2],0,0,0), C1,12); \
    GAPE(o[3]=__builtin_amdgcn_mfma_f32_32x32x16_bf16(PAF(3),VFR(7),o[3],0,0,0), C1,14); \
    }while(0)
  int t=1;
  #undef CMASK
  #define CMASK(P0,P1,t) do{}while(0)
  for(;t+5<NT;t+=2){
    STEP(pB0,pB1,pA0,pA1,t,true,true,true);     WAIT_BAR(3); RESC(); ROT();
    STEP(pA0,pA1,pB0,pB1,t+1,true,true,true);   WAIT_BAR(3); RESC(); ROT();
  }
  #undef CMASK
  #define CMASK(P0,P1,t) do{int jb_=(t)-(NT-4); if(jb_>=0)cmask(P0,P1,jb_,qrel,hi);}while(0)
  #define ENDW(tt) do{ if((tt)+3<NT){WAIT_BAR(3);} else if((tt)+2<NT){WAIT_BAR(2);} else {WAIT_BAR(0);} }while(0)
  for(;t+1<NT;t+=2){
    STEP(pB0,pB1,pA0,pA1,t,(t+3<NT),(t+1<NT),(t+1<NT));       ENDW(t);   RESC(); ROT();
    STEP(pA0,pA1,pB0,pB1,t+1,(t+4<NT),(t+2<NT),(t+2<NT));     ENDW(t+1); RESC(); ROT();
  }
  STEP(pB0,pB1,pA0,pA1,NT-1,false,false,false); RESC();
  { float sacc=pB0[0]+pB0[1]; _Pragma("unroll") for(int r=2;r<16;++r)sacc+=pB0[r]; _Pragma("unroll") for(int r=0;r<16;++r)sacc+=pB1[r]; l_reg+=sacc;
    pw0=(u32x4){PKW(pB0,0),PKW(pB0,2),PKW(pB0,4),PKW(pB0,6)};pw1=(u32x4){PKW(pB0,8),PKW(pB0,10),PKW(pB0,12),PKW(pB0,14)};pw2=(u32x4){PKW(pB1,0),PKW(pB1,2),PKW(pB1,4),PKW(pB1,6)};pw3=(u32x4){PKW(pB1,8),PKW(pB1,10),PKW(pB1,12),PKW(pB1,14)};
    SBAR(); pv(o,vb0+sl_cur,PAF(0),PAF(1),PAF(2),PAF(3)); pv(o+2,vb0+NSLOT*SLOTB+sl_cur,PAF(0),PAF(1),PAF(2),PAF(3)); }
  #undef PKW
  #undef PAF
  #undef VFR
  #undef PIN
  #undef MX3
  #undef GAPA
  #undef GAPB
  #undef GAPE
  #undef EX
  #undef VRD
  #undef VRD2
  #undef KRD
  #undef STEP
  #undef ENDW
  {auto rr=__builtin_amdgcn_permlane32_swap(__float_as_uint(l_reg),__float_as_uint(l_reg),false,false);l_reg=__uint_as_float(rr[0])+__uint_as_float(rr[1]);}
  if(hi==0)wsf[32+r32]=l_reg;asm volatile("s_waitcnt lgkmcnt(0)":::"memory");
  float rli[16];
  #pragma unroll
  for(int r=0;r<16;++r)rli[r]=__builtin_amdgcn_rcpf(wsf[32+crow(r,hi)]);
  bf16*Ow=O+(long)(q0+wid*QBLK)*PO;
  { bf16*stg=(bf16*)(shm+LDS_OST)+wid*2048;
    #pragma unroll
    for(int hf=0;hf<2;++hf){
      #pragma unroll
      for(int r=0;r<16;++r){const int orow=crow(r,hi);
        #pragma unroll
        for(int d0=0;d0<2;++d0)stg[orow*64+d0*32+r32]=__float2bfloat16(o[2*hf+d0][r]*rli[r]);}
      asm volatile("s_waitcnt lgkmcnt(0)":::"memory");
      #pragma unroll
      for(int i=0;i<4;++i){const int row=i*8+(lane>>3),ch=lane&7; const u32x4 v=*(const u32x4*)(stg+row*64+ch*8); ATTN_STORE16(Ow+(long)row*PO+hf*64+ch*8,v);}
      asm volatile("s_waitcnt lgkmcnt(0)":::"memory"); } }
  asm volatile("s_waitcnt lgkmcnt(0)\n\ts_barrier":::"memory");
  #undef DMA_K
  #undef DMA_V
  #undef CMASK
  #undef START
  #undef RESC
  #undef ROT
}
constexpr int ATTN_LDS_BYTES=LDS_BYTES;
#undef SBAR
#undef WAIT_BAR
}

#include <hip/hip_cooperative_groups.h>
namespace cg = cooperative_groups;
#define LAS __attribute__((address_space(3)))
typedef unsigned short u16;
typedef unsigned v4u __attribute__((ext_vector_type(4)));
typedef unsigned v2u __attribute__((ext_vector_type(2)));
typedef float v4f __attribute__((ext_vector_type(4)));
typedef short v8s __attribute__((ext_vector_type(8)));

constexpr int NWAVES = 8, NTHR = 512;
constexpr int BATCH = 8, SEQ = 4096, DM = 1024, MROWS = BATCH * SEQ, MH = MROWS / 2, FF = 2816, NIN = 5896, ZP = 2816, ZPB = 2 * ZP, ZGATE_B = 5 * 512, NLAYER = 2;
constexpr float EPS = 1e-6f;
constexpr float QC2 = 0.125f * 1.4426950408889634f;
constexpr int LDS_BYTES = 147456;

constexpr size_t MiB = 1u << 20, KiB = 1u << 10;
constexpr size_t WS_BAR = 0, CTL_ZERO_BYTES = 64 * KiB;
constexpr size_t WS_W = 2 * MiB, W_LSTRIDE = 49 * MiB;
constexpr size_t WO_13A = 0, WO_2A = 11 * MiB, WO_IN = 16 * MiB + 512 * KiB, WO_PA = 28 * MiB + 512 * KiB, WO_PB = 29 * MiB, WO_PC = 29 * MiB + 512 * KiB,
                 WO_OUT = 30 * MiB + 512 * KiB, WO_13B = 32 * MiB + 512 * KiB, WO_2B = 43 * MiB + 512 * KiB;
constexpr size_t WS_XB = 100 * MiB, WS_ZA = 164 * MiB, WS_O = 340 * MiB, WS_QC = 372 * MiB, WS_KC = 388 * MiB, WS_VC = 404 * MiB, WS_MG = WS_QC  , WS_U = 420 * MiB, WS_CST = 436 * MiB,
                 WS_YA = 444 * MiB, WS_YB = 452 * MiB, WS_YC = 460 * MiB, WS_MIF = 476 * MiB, WS_COS = 477 * MiB, WS_SIN = 481 * MiB, WS_SSP = 485 * MiB,
                 WS_NU = 487 * MiB, WS_NST = 487 * MiB + 256 * KiB, WS_ML = 487 * MiB + 512 * KiB, WS_BL = WS_ML + 4 * KiB, WS_MST = WS_BL + 4 * KiB, WS_END = 488 * MiB;
static_assert((size_t)MH * ZP * 2 <= WS_O - WS_ZA && (size_t)MROWS * FF * 2 <= WS_O - WS_ZA, "z / act region");

__device__ __forceinline__ unsigned f2bf(float f) { unsigned u = __builtin_bit_cast(unsigned, f); return (u + 0x7fffu + ((u >> 16) & 1u)) >> 16; }
typedef float f32x2_ __attribute__((ext_vector_type(2))); typedef __bf16 bf16x2_ __attribute__((ext_vector_type(2)));
__device__ __forceinline__ unsigned pk2(float lo, float hi) { const f32x2_ v = {lo, hi}; const bf16x2_ b = __builtin_convertvector(v, bf16x2_); return __builtin_bit_cast(unsigned, b); }
__device__ __forceinline__ float bflo(unsigned w) { return __uint_as_float(w << 16); }
__device__ __forceinline__ float bfhi(unsigned w) { return __uint_as_float(w & 0xffff0000u); }
__device__ __forceinline__ void unpack8(const v4u r, float* x) { x[0] = bflo(r.x); x[1] = bfhi(r.x); x[2] = bflo(r.y); x[3] = bfhi(r.y); x[4] = bflo(r.z); x[5] = bfhi(r.z); x[6] = bflo(r.w); x[7] = bfhi(r.w); }
__device__ __forceinline__ v4u pack8(const float* x) { v4u o; o.x = pk2(x[0], x[1]); o.y = pk2(x[2], x[3]); o.z = pk2(x[4], x[5]); o.w = pk2(x[6], x[7]); return o; }
__device__ __forceinline__ float sigmoidf_(float x) { return __builtin_amdgcn_rcpf(1.0f + __builtin_amdgcn_exp2f(-1.4426950408889634f * x)); }
__device__ __forceinline__ float siluf_(float x) { return x * __builtin_amdgcn_rcpf(1.0f + __builtin_amdgcn_exp2f(-1.4426950408889634f * x)); }
__device__ __forceinline__ float shl_(float v, int src) { return __int_as_float(__builtin_amdgcn_ds_bpermute(src << 2, __float_as_int(v))); }
__device__ __forceinline__ float shx_(float v, int lane, int o) { return shl_(v, lane ^ o); }
template <int CTRL, int ROWMASK> __device__ __forceinline__ float dpp_(float oldv, float src) {
    return __int_as_float(__builtin_amdgcn_update_dpp(__float_as_int(oldv), __float_as_int(src), CTRL, ROWMASK, 0xF, false));
}
__device__ __forceinline__ float wave_incl_sum(float v, int) {
    v += dpp_<0x111, 0xF>(0.f, v); v += dpp_<0x112, 0xF>(0.f, v); v += dpp_<0x114, 0xF>(0.f, v); v += dpp_<0x118, 0xF>(0.f, v);
    v += dpp_<0x142, 0xA>(0.f, v); v += dpp_<0x143, 0xC>(0.f, v);
    return v;
}
__device__ __forceinline__ float wave_incl_max(float v, int) {
    const float ninf = -__builtin_inff();
    v = fmaxf(v, dpp_<0x111, 0xF>(ninf, v)); v = fmaxf(v, dpp_<0x112, 0xF>(ninf, v)); v = fmaxf(v, dpp_<0x114, 0xF>(ninf, v)); v = fmaxf(v, dpp_<0x118, 0xF>(ninf, v));
    v = fmaxf(v, dpp_<0x142, 0xA>(ninf, v)); v = fmaxf(v, dpp_<0x143, 0xC>(ninf, v));
    return v;
}
__device__ __forceinline__ float lane63_(float v) { return __int_as_float(__builtin_amdgcn_readlane(__float_as_int(v), 63)); }
__device__ __forceinline__ float wave_sum(float v, int lane) { return lane63_(wave_incl_sum(v, lane)); }
__device__ __forceinline__ float wave_max(float v, int lane) { return lane63_(wave_incl_max(v, lane)); }
__device__ __forceinline__ float red8(float v) {
    v += dpp_<0xB1, 0xF>(0.f, v); v += dpp_<0x4E, 0xF>(0.f, v); v += dpp_<0x141, 0xF>(0.f, v);
    return v;
}
__device__ __forceinline__ float red16(float v) { v = red8(v); v += dpp_<0x140, 0xF>(0.f, v); return v; }
__device__ __forceinline__ float logsigmoidf_(float x) { return fminf(x, 0.f) - __logf(1.0f + __expf(-fabsf(x))); }
__device__ __forceinline__ size_t tl(int row, int col, int K) { return (size_t)(row >> 8) * ((size_t)256 * K) + (size_t)(col >> 6) * (256 * 64) + (size_t)((row & 255) * 64 + (col & 63)); }
__device__ __forceinline__ float rstd_from_quarter(const v4f a, int ln) {
    float s = (a.x + a.y) + (a.z + a.w);
    s += __int_as_float(__builtin_amdgcn_ds_bpermute((ln ^ 16) << 2, __float_as_int(s))); s += __int_as_float(__builtin_amdgcn_ds_bpermute((ln ^ 32) << 2, __float_as_int(s)));
    return rsqrtf(s * (1.0f / DM) + EPS);
}
__device__ __forceinline__ float row_rstd4(const float* ssp, int row, int fq, int ln) {
    const v4f a = *(const v4f*)(ssp + (size_t)row * 16 + 4 * fq);
    float s = (a.x + a.y) + (a.z + a.w);
    s += __int_as_float(__builtin_amdgcn_ds_bpermute((ln ^ 16) << 2, __float_as_int(s))); s += __int_as_float(__builtin_amdgcn_ds_bpermute((ln ^ 32) << 2, __float_as_int(s)));
    return rsqrtf(s * (1.0f / DM) + EPS);
}
__device__ __forceinline__ float row_rstd(const float* ssp, int row) {
    const v4f* p = (const v4f*)(ssp + (size_t)row * 16);
    const v4f a = p[0], b = p[1], c = p[2], d = p[3];
    const float s = ((a.x + a.y) + (a.z + a.w)) + ((b.x + b.y) + (b.z + b.w)) + ((c.x + c.y) + (c.z + c.w)) + ((d.x + d.y) + (d.z + d.w));
    return rsqrtf(s * (1.0f / DM) + EPS);
}

namespace pg8 {
__device__ __forceinline__ f32x4 sigmoid4(f32x4 x) {
    const f32x4 z = x * (-1.4426950408889634f); f32x4 e;
    e[0] = __builtin_amdgcn_exp2f(z[0]); e[1] = __builtin_amdgcn_exp2f(z[1]); e[2] = __builtin_amdgcn_exp2f(z[2]); e[3] = __builtin_amdgcn_exp2f(z[3]);
    const f32x4 d = e + 1.0f; f32x4 r;
    r[0] = __builtin_amdgcn_rcpf(d[0]); r[1] = __builtin_amdgcn_rcpf(d[1]); r[2] = __builtin_amdgcn_rcpf(d[2]); r[3] = __builtin_amdgcn_rcpf(d[3]);
    return r;
}
struct EpiSwiglu {
    static constexpr bool PERM = true, AFTER_DRAIN = false;
    static __device__ __forceinline__ bool keep_acc(const Unit&) { return false; }
    bf16_t* O; const float* ssp;
    __device__ __forceinline__ void operator()(const f32x4 (&acc)[2][2][4][2], const Unit& u, int wr, int wc, int, int) const {
        int t_ = threadIdx.x; asm volatile("" : "+v"(t_)); const int fr = t_ & 15, fq = (t_ >> 4) & 3;
        const int row0 = u.pm * BM + wr * 64 + fr, col0 = u.pn * HALF + wc * 32 + 8 * fq;
        v4f pq[2][4];
#pragma unroll
        for (int ai = 0; ai < 2; ++ai)
#pragma unroll
            for (int m = 0; m < 4; ++m) pq[ai][m] = *(const v4f*)(ssp + (size_t)(row0 + ai * HALF + m * 16) * 16 + 4 * fq);
        asm volatile("" ::: "memory");
#pragma unroll
        for (int ai = 0; ai < 2; ++ai)
#pragma unroll
            for (int m = 0; m < 4; ++m) {
                const int row = row0 + ai * HALF + m * 16; const float rs = rstd_from_quarter(pq[ai][m], fq * 16 + fr);
                float h[8];
#pragma unroll
                for (int n = 0; n < 2; ++n) { const f32x4 g = acc[ai][0][m][n] * rs, uu = acc[ai][1][m][n] * rs; const f32x4 hv = (g * sigmoid4(g)) * uu;
                    h[n * 4 + 0] = hv[0]; h[n * 4 + 1] = hv[1]; h[n * 4 + 2] = hv[2]; h[n * 4 + 3] = hv[3]; }
                __builtin_nontemporal_store(pack8(h), (u32x4*)(O + tl(row, col0, FF)));
            }
    }
};
struct EpiResid {
    static constexpr bool PERM = true, AFTER_DRAIN = false;
    static __device__ __forceinline__ bool keep_acc(const Unit&) { return false; }
    const float* x0; bf16_t* xb; float* ssp; float scale;
    __device__ __forceinline__ void operator()(const f32x4 (&acc)[2][2][4][2], const Unit& u, int wr, int wc, int, int) const {
        int t_ = threadIdx.x; asm volatile("" : "+v"(t_)); const int fr = t_ & 15, fq = (t_ >> 4) & 3;
        const int row0 = u.pm * BM + wr * 64 + fr, col0 = u.pn * BM + wc * 32 + 8 * fq;
        u32x4 old[2][4][2];
#pragma unroll
        for (int ai = 0; ai < 2; ++ai)
#pragma unroll
            for (int m = 0; m < 4; ++m)
#pragma unroll
                for (int bj = 0; bj < 2; ++bj) old[ai][m][bj] = *(const u32x4*)(xb + tl(row0 + ai * HALF + m * 16, col0 + bj * HALF, DM));
        asm volatile("" ::: "memory");
#pragma unroll
        for (int ai = 0; ai < 2; ++ai)
#pragma unroll
            for (int m = 0; m < 4; ++m) {
                const int row = row0 + ai * HALF + m * 16; float ss = 0.f;
#pragma unroll
                for (int bj = 0; bj < 2; ++bj) {
                    float b[8], v[8]; unpack8(old[ai][m][bj], b);
#pragma unroll
                    for (int n = 0; n < 2; ++n)
#pragma unroll
                        for (int i = 0; i < 4; ++i) { const float t = b[n * 4 + i] + acc[ai][bj][m][n][i] * scale; v[n * 4 + i] = t; ss += t * t; }
                    *(u32x4*)(xb + tl(row, col0 + bj * HALF, DM)) = pack8(v);
                }
                { const int ln = fq * 16 + fr; ss += shx_(ss, ln, 16); ss += shx_(ss, ln, 32); }
                if (fq == 0) ssp[(size_t)row * 16 + u.pn * 4 + wc] = ss;
            }
    }
};
struct EpiWin {
    static constexpr bool PERM = true, AFTER_DRAIN = false;
    static __device__ __forceinline__ bool keep_acc(const Unit&) { return false; }
    bf16_t* Z; bf16_t* QC; bf16_t* KC; bf16_t* VC; float* mif; const float* ssp; const float* cosT; const float* sinT; const float* gate_b;
    __device__ __forceinline__ void operator()(const f32x4 (&acc)[2][2][4][2], const Unit& u, int wr, int wc, int, int) const {
        int t_ = threadIdx.x; asm volatile("" : "+v"(t_)); const int fr = t_ & 15, fq = (t_ >> 4) & 3;
        const int row0 = u.pm * BM + wr * 64 + fr, tile = u.pn;
        const bool rot = tile >= 5 && tile <= 8;
#pragma unroll
        for (int ab = 0; ab < 4; ++ab) {
            const int ai = ab >> 1;
            v4f pq[2]; v4f cs[2][4];
#pragma unroll
            for (int mm = 0; mm < 2; ++mm) { const int row = row0 + ai * HALF + ((ab & 1) * 2 + mm) * 16;
                pq[mm] = *(const v4f*)(ssp + (size_t)row * 16 + 4 * fq);
                if (rot) { const v4f* cp = (const v4f*)(cosT + (size_t)row * 32 + 8 * fq); const v4f* sp = (const v4f*)(sinT + (size_t)row * 32 + 8 * fq);
                    cs[mm][0] = cp[0]; cs[mm][1] = cp[1]; cs[mm][2] = sp[0]; cs[mm][3] = sp[1]; } }
            asm volatile("" ::: "memory");
#pragma unroll
            for (int mm = 0; mm < 2; ++mm) { const int m = (ab & 1) * 2 + mm;
                const int row = row0 + ai * HALF + m * 16; const float rs = rstd_from_quarter(pq[mm], fq * 16 + fr);
                float v0[8], v1[8];
#pragma unroll
                for (int n = 0; n < 2; ++n)
#pragma unroll
                    for (int i = 0; i < 4; ++i) { v0[n * 4 + i] = acc[ai][0][m][n][i] * rs; v1[n * 4 + i] = acc[ai][1][m][n][i] * rs; }
                bf16_t* zr = Z + (size_t)row * ZP + (tile < 5 ? tile : 0) * 256;
                const int bl_ = row >> 12, sq_ = row & (SEQ - 1);
                if (tile >= 5 && tile <= 8) {
                    const v4f c0 = cs[mm][0], c1 = cs[mm][1], s0 = cs[mm][2], s1 = cs[mm][3];
                    const float cc[8] = {c0.x, c0.y, c0.z, c0.w, c1.x, c1.y, c1.z, c1.w}, sn[8] = {s0.x, s0.y, s0.z, s0.w, s1.x, s1.y, s1.z, s1.w};
                    const float qs = tile < 7 ? QC2 : 1.0f;
                    float o0[8], o1[8];
#pragma unroll
                    for (int i = 0; i < 8; ++i) { o0[i] = (v0[i] * cc[i] - v1[i] * sn[i]) * qs; o1[i] = (v1[i] * cc[i] + v0[i] * sn[i]) * qs; }
                    bf16_t* dst = (tile < 7 ? QC : KC) + ((size_t)((bl_ * 8 + ((tile - 5) & 1) * 4 + wc) * SEQ + sq_)) * 64 + 8 * fq;
                    *(u32x4*)(dst) = pack8(o0);
                    *(u32x4*)(dst + 32) = pack8(o1);
                } else if (tile == 23) {
                    if (wc == 0 && fq == 0) {
                        float* mo = mif + (size_t)row * 8;
                        *(v4f*)(mo) = (v4f){v0[0] + gate_b[0], v0[1] + gate_b[1], v0[2] + gate_b[2], v0[3] + gate_b[3]};
                        *(v4f*)(mo + 4) = (v4f){v0[4] + gate_b[4], v0[5] + gate_b[5], v0[6] + gate_b[6], v0[7] + gate_b[7]};
                    }
                } else if (tile == 9 || tile == 10) {
                    bf16_t* d0 = VC + ((size_t)(((bl_ * 4 + (tile - 9) * 2 + 0) * 2 + (wc >> 1)) * SEQ + sq_)) * 64 + (wc & 1) * 32 + 8 * fq;
                    bf16_t* d1 = VC + ((size_t)(((bl_ * 4 + (tile - 9) * 2 + 1) * 2 + (wc >> 1)) * SEQ + sq_)) * 64 + (wc & 1) * 32 + 8 * fq;
                    *(u32x4*)d0 = pack8(v0); *(u32x4*)d1 = pack8(v1);
                } else {
                    if (tile >= 11) {
                        v2u q0, q1;
#pragma unroll
                        for (int n = 0; n < 2; ++n) { const f32x4 s0 = sigmoid4((f32x4){v0[n * 4], v0[n * 4 + 1], v0[n * 4 + 2], v0[n * 4 + 3]}) * 255.0f, s1 = sigmoid4((f32x4){v1[n * 4], v1[n * 4 + 1], v1[n * 4 + 2], v1[n * 4 + 3]}) * 255.0f;
                            unsigned a = 0u, b = 0u;
                            a = __builtin_amdgcn_cvt_pk_u8_f32(s0[0], 0, a); a = __builtin_amdgcn_cvt_pk_u8_f32(s0[1], 1, a); a = __builtin_amdgcn_cvt_pk_u8_f32(s0[2], 2, a); a = __builtin_amdgcn_cvt_pk_u8_f32(s0[3], 3, a);
                            b = __builtin_amdgcn_cvt_pk_u8_f32(s1[0], 0, b); b = __builtin_amdgcn_cvt_pk_u8_f32(s1[1], 1, b); b = __builtin_amdgcn_cvt_pk_u8_f32(s1[2], 2, b); b = __builtin_amdgcn_cvt_pk_u8_f32(s1[3], 3, b);
                            if (n == 0) { q0.x = a; q1.x = b; } else { q0.y = a; q1.y = b; } }
                        unsigned char* gp = (unsigned char*)Z + (size_t)row * ZPB + ZGATE_B + (tile - 11) * 256 + wc * 32 + 8 * fq;
                        *(v2u*)gp = q0; *(v2u*)(gp + HALF) = q1;
                    } else {
                    *(u32x4*)(zr + wc * 32 + 8 * fq) = pack8(v0);
                    *(u32x4*)(zr + HALF + wc * 32 + 8 * fq) = pack8(v1);
                    }
                }
            }
            asm volatile("" ::: "memory");
        }
    }
};
struct EpiMerge {
    static constexpr bool PERM = true, AFTER_DRAIN = false;
    static __device__ __forceinline__ bool keep_acc(const Unit& u) { return (u.pm >> 6) == 2; }
    const bf16_t* Z; bf16_t* Mg;
    __device__ __forceinline__ void operator()(const f32x4 (&acc)[2][2][4][2], const Unit& u, int wr, int wc, int, int) const {
        int t_ = threadIdx.x; asm volatile("" : "+v"(t_)); const int fr = t_ & 15, fq = (t_ >> 4) & 3;
        const int br = u.pm >> 6, pm = u.pm & 63, pn = u.pn & 3, gb = br < 2 ? br : 2;
        const unsigned char* Zg = (const unsigned char*)Z + ZGATE_B + gb * 1024;
        const int row0 = pm * BM + wr * 64 + fr, col0 = pn * BM + wc * 32 + 8 * fq;
#pragma unroll
        for (int ai = 0; ai < 2; ++ai) {
            v2u gq[4][2]; u32x4 mo[4][2];
#pragma unroll
            for (int m = 0; m < 4; ++m)
#pragma unroll
                for (int bj = 0; bj < 2; ++bj) { const int row = row0 + ai * HALF + m * 16;
                    gq[m][bj] = *(const v2u*)(Zg + (size_t)row * ZPB + col0 + bj * HALF);
                    if (br != 0) mo[m][bj] = *(const u32x4*)(Mg + tl(row, col0 + bj * HALF, DM)); }
            asm volatile("" ::: "memory");
#pragma unroll
            for (int m = 0; m < 4; ++m) {
                const int row = row0 + ai * HALF + m * 16;
#pragma unroll
                for (int bj = 0; bj < 2; ++bj) {
                    float g[8], o[8];
                    { const v2u q = gq[m][bj]; const float k = 1.0f / 255.0f;
                      g[0] = (float)(q.x & 255u) * k; g[1] = (float)((q.x >> 8) & 255u) * k; g[2] = (float)((q.x >> 16) & 255u) * k; g[3] = (float)(q.x >> 24) * k;
                      g[4] = (float)(q.y & 255u) * k; g[5] = (float)((q.y >> 8) & 255u) * k; g[6] = (float)((q.y >> 16) & 255u) * k; g[7] = (float)(q.y >> 24) * k; }
#pragma unroll
                    for (int n = 0; n < 2; ++n)
#pragma unroll
                        for (int i = 0; i < 4; ++i) o[n * 4 + i] = g[n * 4 + i] * acc[ai][bj][m][n][i];
                    if (br != 0) { float p[8]; unpack8(mo[m][bj], p);
#pragma unroll
                        for (int i = 0; i < 8; ++i) o[i] += p[i]; }
                    *(u32x4*)(Mg + tl(row, col0 + bj * HALF, DM)) = pack8(o);
                }
            }
            asm volatile("" ::: "memory");
        }
    }
};
struct MergeOrder {
    StaticOrder base;
    __device__ void init(int M, int N, int G_, int c_) { base.init(M, N, G_, c_); }
    __device__ bool next(int i, Unit& u) const { Unit t; if (!base.next(i >> 2, t)) return false; const int br = i & 3; u.pm = br * 64 + t.pm; u.pn = br * 4 + t.pn; return true; }
    __device__ __forceinline__ void a_ready(const Unit&) const {}
    __device__ __forceinline__ void done(const Unit&) const {}
};
}

__device__ __forceinline__ int map_w13(int n) { const int u = n >= FF ? 1 : 0; const int j = n - u * FF; return 256 * (j >> 7) + 128 * u + (j & 127); }
__device__ __forceinline__ int map_win(int n) {
    if (n < 1280) return n;
    if (n < 1288) return 23 * 256 + (n - 1280);
    if (n < 2312) { const int c = n - 1288, tile = 5 + (c >> 8), cl = c & 255, hh = cl >> 6, r = cl & 63; return tile * 256 + (r >> 5) * 128 + hh * 32 + (r & 31); }
    if (n < 2824) return 9 * 256 + (n - 2312);
    return 11 * 256 + (n - 2824);
}
template <int MAP> __device__ __forceinline__ void transpose_item(const float* __restrict__ W, const float* __restrict__ gk, int K, int N, u16* __restrict__ WT, LAS float* scr, int item, int lane) {
    const int nblk = (N + 31) >> 5, kb = item / nblk, nb = item - kb * nblk, k0 = 64 * kb, n0 = 32 * nb;
    const int nn = n0 + (lane & 31); const bool ok = nn < N;
    float wv[32];
#pragma unroll
    for (int i = 0; i < 32; ++i) { const int kk = 2 * i + (lane >> 5); wv[i] = ok ? W[(size_t)(k0 + kk) * N + nn] : 0.f; }
#pragma unroll
    for (int i = 0; i < 32; ++i) { const int kk = 2 * i + (lane >> 5); float w = wv[i]; if (gk) w *= gk[k0 + kk]; scr[kk * 33 + (lane & 31)] = w; }
    asm volatile("s_waitcnt lgkmcnt(0)" ::: "memory");
    const int c = lane & 7;
#pragma unroll
    for (int j = 0; j < 4; ++j) { const int n = (lane >> 3) + 8 * j; const LAS float* s = scr + (8 * c) * 33 + n;
        if (n0 + n < N) {
            const int dest = MAP == 1 ? map_w13(n0 + n) : (MAP == 2 ? map_win(n0 + n) : (n0 + n));
            v4u o; o.x = pk2(s[0 * 33], s[1 * 33]); o.y = pk2(s[2 * 33], s[3 * 33]); o.z = pk2(s[4 * 33], s[5 * 33]); o.w = pk2(s[6 * 33], s[7 * 33]);
            *(v4u*)(WT + tl(dest, k0 + 8 * c, K)) = o; } }
    asm volatile("s_waitcnt lgkmcnt(0)" ::: "memory");
}

struct Args { const void* in[23]; float* out; unsigned char* ws; };

__device__ __forceinline__ void prologue(const Args& A, unsigned char* ws, LAS unsigned char* lds, int gw, int NGW, int wave, int lane) {
    LAS float* scr = (LAS float*)(lds + wave * 16384);
    int base = 0;
    for (int l = 0; l < NLAYER; ++l) {
        unsigned char* wl = ws + WS_W + (size_t)l * W_LSTRIDE;
        const float* n1 = (const float*)A.in[2] + l * DM; const float* nm = (const float*)A.in[5] + l * DM; const float* n2 = (const float*)A.in[19] + l * DM;
        { const int nit = 16 * 176; for (int it = (gw - base + NGW) % NGW; it < nit; it += NGW) transpose_item<1>((const float*)A.in[3] + (size_t)l * DM * 2 * FF, n1, DM, 2 * FF, (u16*)(wl + WO_13A), scr, it, lane); base = (base + nit) % NGW; }
        { const int nit = 44 * 32;  for (int it = (gw - base + NGW) % NGW; it < nit; it += NGW) transpose_item<0>((const float*)A.in[4] + (size_t)l * FF * DM, nullptr, FF, DM, (u16*)(wl + WO_2A), scr, it, lane); base = (base + nit) % NGW; }
        { const int nit = 16 * 185; for (int it = (gw - base + NGW) % NGW; it < nit; it += NGW) transpose_item<2>((const float*)A.in[6] + (size_t)l * DM * NIN, nm, DM, NIN, (u16*)(wl + WO_IN), scr, it, lane); base = (base + nit) % NGW; }
        { const int nit = 4 * 32;   for (int it = (gw - base + NGW) % NGW; it < nit; it += NGW) transpose_item<0>((const float*)A.in[15] + (size_t)l * 256 * DM, nullptr, 256, DM, (u16*)(wl + WO_PA), scr, it, lane); base = (base + nit) % NGW; }
        { const int nit = 4 * 32;   for (int it = (gw - base + NGW) % NGW; it < nit; it += NGW) transpose_item<0>((const float*)A.in[16] + (size_t)l * 256 * DM, nullptr, 256, DM, (u16*)(wl + WO_PB), scr, it, lane); base = (base + nit) % NGW; }
        { const int nit = 4 * 32;   for (int it = (gw - base + NGW) % NGW; it < nit; it += NGW) transpose_item<0>((const float*)A.in[17] + (size_t)l * 512 * DM, nullptr, 256, DM, (u16*)(wl + WO_PC), scr, it, lane); base = (base + nit) % NGW; }
        { const int nit = 4 * 32;   for (int it = (gw - base + NGW) % NGW; it < nit; it += NGW) transpose_item<0>((const float*)A.in[17] + (size_t)l * 512 * DM + (size_t)256 * DM, nullptr, 256, DM, (u16*)(wl + WO_PC + 512 * KiB), scr, it, lane); base = (base + nit) % NGW; }
        { const int nit = 16 * 32;  for (int it = (gw - base + NGW) % NGW; it < nit; it += NGW) transpose_item<0>((const float*)A.in[18] + (size_t)l * DM * DM, nullptr, DM, DM, (u16*)(wl + WO_OUT), scr, it, lane); base = (base + nit) % NGW; }
        { const int nit = 16 * 176; for (int it = (gw - base + NGW) % NGW; it < nit; it += NGW) transpose_item<1>((const float*)A.in[20] + (size_t)l * DM * 2 * FF, n2, DM, 2 * FF, (u16*)(wl + WO_13B), scr, it, lane); base = (base + nit) % NGW; }
        { const int nit = 44 * 32;  for (int it = (gw - base + NGW) % NGW; it < nit; it += NGW) transpose_item<0>((const float*)A.in[21] + (size_t)l * FF * DM, nullptr, FF, DM, (u16*)(wl + WO_2B), scr, it, lane); base = (base + nit) % NGW; }
        { u16* z0 = (u16*)(wl + WO_IN) + (size_t)23 * 256 * DM; const int nch = 16 * 248 * 8;
          for (int i = gw * 64 + lane; i < nch; i += NGW * 64) { const int kb = i / (248 * 8), r = i - kb * (248 * 8); *(v4u*)(z0 + (size_t)kb * (256 * 64) + 8 * 64 + (size_t)r * 8) = (v4u){0u, 0u, 0u, 0u}; } }
    }
    const float* x = (const float*)A.in[0]; const int* pos = (const int*)A.in[1];
    u16* xb = (u16*)(ws + WS_XB); float* ssp = (float*)(ws + WS_SSP); float* cosT = (float*)(ws + WS_COS); float* sinT = (float*)(ws + WS_SIN);
    for (int row = gw; row < MROWS; row += NGW) {
        const v4f* xr = (const v4f*)(x + (size_t)row * DM) + lane; v4f v[4]; float s = 0.f;
#pragma unroll
        for (int j = 0; j < 4; ++j) { v[j] = xr[64 * j]; s += (v[j].x * v[j].x + v[j].y * v[j].y) + (v[j].z * v[j].z + v[j].w * v[j].w); }
        s = wave_sum(s, lane);
#pragma unroll
        for (int j = 0; j < 4; ++j) { v2u w; w.x = pk2(v[j].x, v[j].y); w.y = pk2(v[j].z, v[j].w); *(v2u*)(xb + tl(row, 4 * lane + 256 * j, DM)) = w; }
        if (lane < 16) ssp[(size_t)row * 16 + lane] = lane == 0 ? s : 0.f;
        if (lane < 32) { const float inv = 1.0f / powf(10000.0f, (float)lane * (1.0f / 32.0f)); const float ang = (float)pos[row] * inv; cosT[(size_t)row * 32 + lane] = cosf(ang); sinT[(size_t)row * 32 + lane] = sinf(ang); }
    }
}

#define LBAR() do { asm volatile("s_waitcnt lgkmcnt(0)" ::: "memory"); __builtin_amdgcn_s_barrier(); asm volatile("" ::: "memory"); } while (0)
constexpr int CWL_OFF = 100 * 1024;
__device__ __forceinline__ void stage_conv_weights(const float* cw, const float* cb, LAS unsigned char* lds, int tid) {
    LAS float* L = (LAS float*)(lds + CWL_OFF);
    const float a0 = cw[tid], a1 = cw[tid + 512], a2 = cw[tid + 1024], a3 = cw[tid + 1536], b0 = cb[tid & 511];
    L[tid] = a0; L[tid + 512] = a1; L[tid + 1024] = a2; L[tid + 1536] = a3; L[2048 + (tid & 511)] = b0;
    LBAR();
}
struct PoolIn { v4u u0, u1; v4f w0, w1; };
__device__ __forceinline__ PoolIn pool_load(const u16* Z, const float* pw, int un, int tid) {
    const int g = un >> 8, tb = un & 63, bl = (un >> 6) & 3; const int r0 = bl * SEQ + tb * 64;
    const int rr = tid >> 3, cg8 = (tid & 7) * 8;
    PoolIn I; const bool ok0 = tb * 64 - 16 + rr >= 0;
    I.u0 = *(const v4u*)(Z + (size_t)(ok0 ? r0 - 16 + rr : r0) * ZP + g * 64 + cg8);
    I.u1 = *(const v4u*)(Z + (size_t)(r0 + 48 + (rr & 15)) * ZP + g * 64 + cg8);
    I.w0 = *(const v4f*)(pw + g * 4096 + tid * 8); I.w1 = *(const v4f*)(pw + g * 4096 + tid * 8 + 4);
    return I;
}
__device__ __forceinline__ void pool_compute(const PoolIn& I, u16* YA, const float* pscale, LAS unsigned char* lds, int un, int tid) {
    const int g = un >> 8, tb = un & 63, bl = (un >> 6) & 3; const int r0 = bl * SEQ + tb * 64;
    constexpr int PLP = 72;
    LAS float* Uf = (LAS float*)lds;
    LAS u16* Pb = (LAS u16*)(lds + 20800);
    LAS u16* WgT = Pb + 64 * PLP;
    const int rr = tid >> 3, cg8 = (tid & 7) * 8, lane = tid & 63, wave = tid >> 6;
    { float x[8]; unpack8(I.u0, x); const float keep0 = tb * 64 - 16 + rr >= 0 ? 1.0f : 0.0f;
#pragma unroll
      for (int i = 0; i < 8; ++i) Uf[rr * 65 + cg8 + i] = x[i] * keep0;
      if (rr < 16) { unpack8(I.u1, x);
#pragma unroll
        for (int i = 0; i < 8; ++i) Uf[(rr + 64) * 65 + cg8 + i] = x[i]; }
      const float wv[8] = {I.w0.x, I.w0.y, I.w0.z, I.w0.w, I.w1.x, I.w1.y, I.w1.z, I.w1.w};
#pragma unroll
      for (int i = 0; i < 8; ++i) WgT[(cg8 + i) * PLP + rr] = (u16)f2bf(wv[i]); }
    LBAR();
    { const int w = 2 << g, t = rr, tpos = tb * 64 + t; const float rc = 1.0f / (float)(tpos + 1 < w ? tpos + 1 : w);
        float s[8], u0[8];
#pragma unroll
        for (int i = 0; i < 8; ++i) { u0[i] = Uf[(16 + t) * 65 + cg8 + i]; s[i] = u0[i] + Uf[(15 + t) * 65 + cg8 + i]; }
        if (g >= 1) {
#pragma unroll
            for (int i = 0; i < 8; ++i) s[i] += Uf[(14 + t) * 65 + cg8 + i] + Uf[(13 + t) * 65 + cg8 + i]; }
        if (g >= 2) {
#pragma unroll
            for (int i = 0; i < 8; ++i) s[i] += (Uf[(12 + t) * 65 + cg8 + i] + Uf[(11 + t) * 65 + cg8 + i]) + (Uf[(10 + t) * 65 + cg8 + i] + Uf[(9 + t) * 65 + cg8 + i]); }
        if (g >= 3) {
#pragma unroll
            for (int i = 0; i < 8; ++i) { float a = 0.f;
#pragma unroll
                for (int j = 8; j < 16; ++j) a += Uf[(16 + t - j) * 65 + cg8 + i];
                s[i] += a; } }
        float p[8];
#pragma unroll
        for (int i = 0; i < 8; ++i) p[i] = s[i] * rc - u0[i];
        *(LAS v4u*)(Pb + t * PLP + cg8) = pack8(p); }
    LBAR();
    {
        const int tr = wave >> 1, tc0 = (wave & 1) * 2, fr = lane & 15, fq = lane >> 4;
        v4f a0 = {0.f, 0.f, 0.f, 0.f}, a1 = {0.f, 0.f, 0.f, 0.f};
#pragma unroll
        for (int kk = 0; kk < 2; ++kk) { const v8s a = *(const LAS v8s*)(Pb + (16 * tr + fr) * PLP + 32 * kk + 8 * fq);
            a0 = __builtin_amdgcn_mfma_f32_16x16x32_bf16(a, *(const LAS v8s*)(WgT + (16 * tc0 + fr) * PLP + 32 * kk + 8 * fq), a0, 0, 0, 0);
            a1 = __builtin_amdgcn_mfma_f32_16x16x32_bf16(a, *(const LAS v8s*)(WgT + (16 * tc0 + 16 + fr) * PLP + 32 * kk + 8 * fq), a1, 0, 0, 0); }
#pragma unroll
        for (int rg = 0; rg < 4; ++rg) { const int t = 16 * tr + 4 * fq + rg; Uf[t * 65 + 16 * tc0 + fr] = a0[rg]; Uf[t * 65 + 16 * tc0 + 16 + fr] = a1[rg]; } }
    LBAR();
    { const int t = rr; float o[8];
#pragma unroll
        for (int i = 0; i < 8; ++i) o[i] = Uf[t * 65 + cg8 + i] * pscale[g * 64 + cg8 + i];
        *(v4u*)(YA + tl(r0 + t, g * 64 + cg8, 256)) = pack8(o); }
    LBAR();
}

__device__ __forceinline__ void conv8r(const v4u* rows, const LAS float* cwL, int ch0, float* o, int tpos) {
#pragma unroll
    for (int i = 0; i < 8; ++i) o[i] = cwL[2048 + ch0 + i];
#pragma unroll
    for (int j = 0; j < 4; ++j) { float x[8]; unpack8(rows[j], x); const float keep = tpos - 3 + j >= 0 ? 1.0f : 0.0f;
#pragma unroll
        for (int i = 0; i < 8; ++i) o[i] += cwL[j * 512 + ch0 + i] * (x[i] * keep); }
#pragma unroll
    for (int i = 0; i < 8; ++i) o[i] = siluf_(o[i]);
}
__device__ __forceinline__ void load4rows(const u16* Z, int r, int tpos, int zcol, v4u* rows) {
#pragma unroll
    for (int j = 0; j < 4; ++j) { const bool ok = tpos - 3 + j >= 0; rows[j] = *(const v4u*)(Z + (size_t)(ok ? r - 3 + j : r) * ZP + zcol); }
}
constexpr int LP = 72;
__device__ __forceinline__ v8s lds_frag(const LAS u16* base, int row, int koff) { return *(const LAS v8s*)(base + row * LP + koff); }

struct M1In { v4u k[4]; v4u v; float ip, fp; };
__device__ __forceinline__ M1In m1_load(const u16* Z, const float* mif, int un, int tid) {
    const int c = un & 63, h = (un >> 6) & 3, bl = un >> 8; const int r0 = bl * SEQ + c * 64;
    const int s = tid >> 3, dg = tid & 7;
    M1In I; load4rows(Z, r0 + s, c * 64 + s, 2 * 256 + h * 64 + dg * 8, I.k);
    I.v = *(const v4u*)(Z + (size_t)(r0 + s) * ZP + 3 * 256 + h * 64 + dg * 8);
    I.ip = mif[(size_t)(r0 + (tid & 63)) * 8 + h]; I.fp = mif[(size_t)(r0 + (tid & 63)) * 8 + 4 + h];
    return I;
}
__device__ __forceinline__ void m1_compute(const M1In& I, float* U, float* nU, float* mlv, float* blv, LAS unsigned char* lds, int un, int tid) {
    const int h = (un >> 6) & 3;
    const int lane = tid & 63, wave = tid >> 6;
    LAS float* wk = (LAS float*)lds;
    LAS u16* Vt = (LAS u16*)(lds + 1024);
    LAS u16* KWt = Vt + 64 * LP;
    const LAS float* cwL = (const LAS float*)(lds + CWL_OFF);
    if (wave == 0) {
        const float bc = wave_incl_sum(logsigmoidf_(I.fp), lane); const float blast = lane63_(bc);
        const float g = blast - bc + I.ip; const float mx = wave_max(g, lane);
        wk[lane] = __expf(g - mx);
        if (lane == 0) { wk[64] = mx; wk[65] = blast; }
    }
    const int s = tid >> 3, dg = tid & 7;
    float kv[8]; conv8r(I.k, cwL, 256 + h * 64 + dg * 8, kv, (un & 63) * 64 + s);
    float vv[8]; unpack8(I.v, vv);
    LBAR();
    { const float w = wk[s] * 0.125f;
#pragma unroll
        for (int i = 0; i < 8; ++i) { KWt[(dg * 8 + i) * LP + s] = (u16)f2bf(kv[i] * w); Vt[(dg * 8 + i) * LP + s] = (u16)f2bf(vv[i]); } }
    LBAR();
    { const int tr = wave >> 1, tc0 = (wave & 1) * 2, fr = lane & 15, fq = lane >> 4;
        v4f a0 = {0.f, 0.f, 0.f, 0.f}, a1 = {0.f, 0.f, 0.f, 0.f};
#pragma unroll
        for (int kk = 0; kk < 2; ++kk) { const v8s a = lds_frag(Vt, 16 * tr + fr, 32 * kk + 8 * fq);
            a0 = __builtin_amdgcn_mfma_f32_16x16x32_bf16(a, lds_frag(KWt, 16 * tc0 + fr, 32 * kk + 8 * fq), a0, 0, 0, 0);
            a1 = __builtin_amdgcn_mfma_f32_16x16x32_bf16(a, lds_frag(KWt, 16 * tc0 + 16 + fr, 32 * kk + 8 * fq), a1, 0, 0, 0); }
        float* Uo = U + (size_t)un * 4096;
#pragma unroll
        for (int rg = 0; rg < 4; ++rg) { const int e = 16 * tr + 4 * fq + rg; Uo[e * 64 + 16 * tc0 + fr] = a0[rg]; Uo[e * 64 + 16 * tc0 + 16 + fr] = a1[rg]; } }
    { float x[8]; unpack8(*(const LAS v4u*)(KWt + s * LP + dg * 8), x); float sN = ((x[0] + x[1]) + (x[2] + x[3])) + ((x[4] + x[5]) + (x[6] + x[7]));
      sN = red8(sN); if (dg == 0) nU[un * 64 + s] = sN; }
    if (tid == 0) { mlv[un] = wk[64]; blv[un] = wk[65]; }
    LBAR();
}

__device__ __forceinline__ void m2_phase(const float* __restrict__ U, const float* __restrict__ nU, const float* __restrict__ mlv, const float* __restrict__ blv,
                                         u16* __restrict__ Cst, float* __restrict__ nst, float* __restrict__ mst, LAS unsigned char* lds, int G, int bx, int tid) {
    const int per = (16 * 4160 + G - 1) / G, e0 = bx * per;
    const int pfirst = e0 / 4160;
    LAS float* decs = (LAS float*)lds; LAS float* scs = decs + 128;
    const int lane = tid & 63, wave = tid >> 6;
    if (wave < 2 && pfirst + wave < 16) {
        const int un = (pfirst + wave) * 64 + lane; const float ml = mlv[un], b = blv[un];
        const float Bincl = wave_incl_sum(b, lane);
        const float Mnext = fmaxf(0.f, wave_incl_max(ml - Bincl, lane));
        float Mcur = shl_(Mnext, (lane - 1) & 63); if (lane == 0) Mcur = 0.f;
        const float mcur = Mcur + (Bincl - b), mnext = Mnext + Bincl;
        decs[wave * 64 + lane] = __expf(b + mcur - mnext); scs[wave * 64 + lane] = __expf(ml - mnext);
        mst[un] = mcur;
    }
    LBAR();
    for (int t = tid; t < per; t += NTHR) { const int gt = e0 + t; if (gt < 16 * 4160) {
        const int p = gt / 4160, idx = gt - p * 4160, w = (p - pfirst) * 64; float st = 0.f;
        if (idx < 4096) { const float* up = U + (size_t)p * 64 * 4096 + idx; u16* cp = Cst + (size_t)p * 64 * 4096 + idx;
            float uv[64];
#pragma unroll
            for (int c = 0; c < 64; ++c) uv[c] = up[(size_t)c * 4096];
#pragma unroll
            for (int c = 0; c < 64; ++c) { cp[(size_t)c * 4096] = (u16)f2bf(st); st = decs[w + c] * st + scs[w + c] * uv[c]; } }
        else { const float* up = nU + p * 64 * 64 + idx - 4096; float* np = nst + p * 64 * 64 + idx - 4096;
            float uv[64];
#pragma unroll
            for (int c = 0; c < 64; ++c) uv[c] = up[c * 64];
            asm volatile("" ::: "memory");
#pragma unroll
            for (int c = 0; c < 64; ++c) { np[c * 64] = st; st = decs[w + c] * st + scs[w + c] * uv[c]; } } } }
    LBAR();
}

struct M3In { v4u q[4], k[4], v, c, mo; float ip, fp, nvv, mc; };
__device__ __forceinline__ M3In m3_load(const u16* Z, const float* mif, const u16* Cst, const float* nst, const float* mst, int un, int tid) {
    const int c = un & 63, h = (un >> 6) & 3, bl = un >> 8; const int r0 = bl * SEQ + c * 64;
    const int s = tid >> 3, dg = tid & 7;
    M3In I; load4rows(Z, r0 + s, c * 64 + s, 1 * 256 + h * 64 + dg * 8, I.q); load4rows(Z, r0 + s, c * 64 + s, 2 * 256 + h * 64 + dg * 8, I.k);
    I.v = *(const v4u*)(Z + (size_t)(r0 + s) * ZP + 3 * 256 + h * 64 + dg * 8);
    I.mo = *(const v4u*)(Z + (size_t)(r0 + s) * ZP + 4 * 256 + h * 64 + dg * 8);
    I.c = *(const v4u*)(Cst + (size_t)un * 4096 + s * 64 + dg * 8);
    I.ip = mif[(size_t)(r0 + (tid & 63)) * 8 + h]; I.fp = mif[(size_t)(r0 + (tid & 63)) * 8 + 4 + h]; I.nvv = nst[un * 64 + (tid & 63)]; I.mc = mst[un];
    return I;
}
__device__ __forceinline__ void m3_compute(const M3In& I, const float* mnorm, u16* YB, LAS unsigned char* lds, int un, int tid) {
    const int c = un & 63, h = (un >> 6) & 3, bl = un >> 8; const int r0 = bl * SEQ + c * 64;
    const int lane = tid & 63, wave = tid >> 6;
    LAS float* av = (LAS float*)lds;
    LAS float* Mx = av + 64;
    LAS float* wi = Mx + 64;
    LAS float* emt = wi + 64;
    LAS float* nv = emt + 64;
    LAS float* dinv = nv + 64;
    LAS u16* Qs = (LAS u16*)(lds + 2048);
    LAS u16* Ks = Qs + 64 * LP;
    LAS u16* Vt = Ks + 64 * LP;
    LAS u16* Cs = Vt + 64 * LP;
    LAS u16* SC = Cs + 64 * LP;
    LAS float* NUM = (LAS float*)(SC + 64 * LP);
    const LAS float* cwL = (const LAS float*)(lds + CWL_OFF);
    if (wave == 0) {
        const float mc = I.mc;
        const float bc = wave_incl_sum(logsigmoidf_(I.fp), lane);
        const float a = I.ip - bc; const float pm = wave_incl_max(a, lane); const float MM = fmaxf(mc, pm);
        av[lane] = a; Mx[lane] = MM; wi[lane] = __expf(mc - MM); emt[lane] = __expf(-bc - MM); nv[lane] = I.nvv;
    }
    const int s = tid >> 3, dg = tid & 7;
    { float q[8], k[8], v[8];
        conv8r(I.q, cwL, h * 64 + dg * 8, q, c * 64 + s);
        conv8r(I.k, cwL, 256 + h * 64 + dg * 8, k, c * 64 + s);
#pragma unroll
        for (int i = 0; i < 8; ++i) k[i] *= 0.125f;
        unpack8(I.v, v);
        *(LAS v4u*)(Qs + s * LP + dg * 8) = pack8(q);
        *(LAS v4u*)(Ks + s * LP + dg * 8) = pack8(k);
#pragma unroll
        for (int i = 0; i < 8; ++i) Vt[(dg * 8 + i) * LP + s] = (u16)f2bf(v[i]);
        *(LAS v4u*)(Cs + s * LP + dg * 8) = I.c; }
    LBAR();
    const int tr = wave >> 1, tc0 = (wave & 1) * 2, fr = lane & 15, fq = lane >> 4;
    {
        v4f a0 = {0.f, 0.f, 0.f, 0.f}, a1 = {0.f, 0.f, 0.f, 0.f};
#pragma unroll
        for (int kk = 0; kk < 2; ++kk) { const v8s a = lds_frag(Qs, 16 * tr + fr, 32 * kk + 8 * fq);
            a0 = __builtin_amdgcn_mfma_f32_16x16x32_bf16(a, lds_frag(Ks, 16 * tc0 + fr, 32 * kk + 8 * fq), a0, 0, 0, 0);
            a1 = __builtin_amdgcn_mfma_f32_16x16x32_bf16(a, lds_frag(Ks, 16 * tc0 + 16 + fr, 32 * kk + 8 * fq), a1, 0, 0, 0); }
#pragma unroll
        for (int rg = 0; rg < 4; ++rg) { const int t = 16 * tr + 4 * fq + rg; const float mt = Mx[t];
            const int s0 = 16 * tc0 + fr, s1 = s0 + 16;
            const float w0 = s0 <= t ? __expf(av[s0] - mt) : 0.f, w1 = s1 <= t ? __expf(av[s1] - mt) : 0.f;
            SC[t * LP + s0] = (u16)f2bf(a0[rg] * w0); SC[t * LP + s1] = (u16)f2bf(a1[rg] * w1); } }
    LBAR();
    {
        v4f a0 = {0.f, 0.f, 0.f, 0.f}, a1 = {0.f, 0.f, 0.f, 0.f}, c0 = {0.f, 0.f, 0.f, 0.f}, c1 = {0.f, 0.f, 0.f, 0.f};
#pragma unroll
        for (int kk = 0; kk < 2; ++kk) { const v8s a = lds_frag(SC, 16 * tr + fr, 32 * kk + 8 * fq), q = lds_frag(Qs, 16 * tr + fr, 32 * kk + 8 * fq);
            a0 = __builtin_amdgcn_mfma_f32_16x16x32_bf16(a, lds_frag(Vt, 16 * tc0 + fr, 32 * kk + 8 * fq), a0, 0, 0, 0);
            a1 = __builtin_amdgcn_mfma_f32_16x16x32_bf16(a, lds_frag(Vt, 16 * tc0 + 16 + fr, 32 * kk + 8 * fq), a1, 0, 0, 0);
            c0 = __builtin_amdgcn_mfma_f32_16x16x32_bf16(q, lds_frag(Cs, 16 * tc0 + fr, 32 * kk + 8 * fq), c0, 0, 0, 0);
            c1 = __builtin_amdgcn_mfma_f32_16x16x32_bf16(q, lds_frag(Cs, 16 * tc0 + 16 + fr, 32 * kk + 8 * fq), c1, 0, 0, 0); }
#pragma unroll
        for (int rg = 0; rg < 4; ++rg) { const int t = 16 * tr + 4 * fq + rg; const float w = wi[t];
            NUM[t * 65 + 16 * tc0 + fr] = a0[rg] + w * c0[rg]; NUM[t * 65 + 16 * tc0 + 16 + fr] = a1[rg] + w * c1[rg]; } }
    { const int t = s; float a[8], q[8]; unpack8(*(const LAS v4u*)(SC + t * LP + dg * 8), a); unpack8(*(const LAS v4u*)(Qs + t * LP + dg * 8), q);
        float rs = ((a[0] + a[1]) + (a[2] + a[3])) + ((a[4] + a[5]) + (a[6] + a[7])), qn = 0.f;
#pragma unroll
        for (int i = 0; i < 8; ++i) qn += q[i] * nv[dg * 8 + i];
        rs = red8(rs); qn = red8(qn);
        if (dg == 0) { const float den = rs + wi[t] * qn; dinv[t] = 1.0f / fmaxf(fabsf(den), emt[t]); } }
    LBAR();
    {
        const int t = s; const float di = dinv[t]; float hv[8]; float sm = 0.f;
#pragma unroll
        for (int i = 0; i < 8; ++i) { hv[i] = NUM[t * 65 + dg * 8 + i] * di; sm += hv[i]; }
        sm = red8(sm);
        const float mu = sm * (1.0f / 64.0f); float vs = 0.f;
#pragma unroll
        for (int i = 0; i < 8; ++i) { hv[i] -= mu; vs += hv[i] * hv[i]; }
        vs = red8(vs);
        const float rstd = rsqrtf(vs * (1.0f / 64.0f) + EPS);
        float og[8]; unpack8(I.mo, og);
        float o[8];
#pragma unroll
        for (int i = 0; i < 8; ++i) o[i] = hv[i] * rstd * mnorm[h * 64 + dg * 8 + i] * sigmoidf_(og[i]);
        *(v4u*)(YB + tl(r0 + t, h * 64 + dg * 8, 256)) = pack8(o); }
    LBAR();
}

__device__ __forceinline__ void attn_post(const u16* O, u16* YC, const float* dlam, const float* dnorm, float lambda_init, int gt, int nthreads, int lane) {
    float sa = dlam[lane] * dlam[64 + lane], sb = dlam[128 + lane] * dlam[192 + lane];
    sa = wave_sum(sa, lane); sb = wave_sum(sb, lane);
    const float lam = expf(sa) - expf(sb) + lambda_init, post = 1.0f - lambda_init;
    const int sub = gt & 15;
    float gn[8];
#pragma unroll
    for (int i = 0; i < 8; ++i) gn[i] = dnorm[sub * 8 + i] * post;
    const int stride = nthreads >> 4;
    for (int item0 = gt >> 4; item0 < MH * 4; item0 += 8 * stride) {
        v4u ra[8], rb[8];
#pragma unroll
        for (int q = 0; q < 8; ++q) { const int item = item0 + q * stride < MH * 4 ? item0 + q * stride : item0; const int row = item >> 2, hh = item & 3;
            ra[q] = *(const v4u*)(O + (size_t)row * 1024 + (2 * hh) * 128 + sub * 8); rb[q] = *(const v4u*)(O + (size_t)row * 1024 + (2 * hh + 1) * 128 + sub * 8); }
#pragma unroll
        for (int q = 0; q < 8; ++q) { const int item = item0 + q * stride; const int row = item >> 2, hh = item & 3; float a[8], b[8], d[8]; float ss = 0.f;
            unpack8(ra[q], a); unpack8(rb[q], b);
#pragma unroll
            for (int i = 0; i < 8; ++i) { d[i] = a[i] - lam * b[i]; ss += d[i] * d[i]; }
            ss = red16(ss);
            const float r = rsqrtf(ss * (1.0f / 128.0f) + EPS);
#pragma unroll
            for (int i = 0; i < 8; ++i) d[i] *= r * gn[i];
            if (item < MH * 4) *(v4u*)(YC + (size_t)(hh >> 1) * MH * 256 + tl(row, (hh & 1) * 128 + sub * 8, 256)) = pack8(d); }
    }
}

#define RLX_AGENT __ATOMIC_RELAXED, __HIP_MEMORY_SCOPE_AGENT
#define XB_TMO      128
#define XB_XCNT(j)  (256  + 64 * (j))
#define XB_XSUB(j)  (1280 + 64 * (j))
#define XB_XGEN(j)  (2304 + 64 * (j))
#define XB_TOP      3328
#define XB_TOPGEN   3392
#define XCD_BAR_WORDS 3456
#define XB_SPIN_CAP (1u << 18)

__device__ __forceinline__ unsigned xb_ld(unsigned* p)              { return __hip_atomic_load(p, __ATOMIC_RELAXED, __HIP_MEMORY_SCOPE_AGENT); }
__device__ __forceinline__ unsigned xb_add(unsigned* p, unsigned v) { return __hip_atomic_fetch_add(p, v, __ATOMIC_RELAXED, __HIP_MEMORY_SCOPE_AGENT); }
__device__ __forceinline__ unsigned xb_xcc_id() { return (unsigned)__builtin_amdgcn_s_getreg((3 << 11) | 20) & 0xFu; }
#define XB_SPIN(cond, bar) do { unsigned _sp = 0; while (cond) { __builtin_amdgcn_s_sleep(1); \
    if ((++_sp & 255u) == 0u) { if (xb_ld(&(bar)[XB_TMO])) break; if (_sp > XB_SPIN_CAP) { atomicAdd(&(bar)[XB_TMO], 1u); break; } } } } while (0)

struct XcdBarrier {
    unsigned* bar; unsigned x;
    volatile LAS unsigned* st;
};

__device__ __forceinline__ XcdBarrier xcd_barrier_post(unsigned* bar, volatile LAS unsigned* st) {
    XcdBarrier b; b.bar = bar; b.x = xb_xcc_id(); b.st = st;
    if (threadIdx.x == 0) (void)xb_add(&bar[XB_XCNT(b.x)], 1u);
    return b;
}
__device__ __forceinline__ void xcd_barrier_complete(unsigned* bar, unsigned x, unsigned& nloc, unsigned& nx) {
    const unsigned G = gridDim.x * gridDim.y * gridDim.z;
    unsigned sum, cnt, mine, sp = 0u;
    for (;;) {
        sum = 0u; cnt = 0u; mine = 0u;
#pragma unroll
        for (unsigned j = 0; j < 16; ++j) { const unsigned c = xb_ld(&bar[XB_XCNT(j)]); sum += c; cnt += (c > 0u) ? 1u : 0u; mine = (j == x) ? c : mine; }
        if (sum == G) break;
        __builtin_amdgcn_s_sleep(1);
        if ((++sp & 255u) == 0u) { if (xb_ld(&bar[XB_TMO])) break; if (sp > XB_SPIN_CAP) { atomicAdd(&bar[XB_TMO], 1u); break; } }
    }
    nloc = mine > 0u ? mine : 1u; nx = cnt > 0u ? cnt : 1u;
}

__device__ __forceinline__ void xcd_barrier(const XcdBarrier& b) {
    asm volatile("s_waitcnt vmcnt(0)" ::: "memory");
    __syncthreads();
    if (threadIdx.x == 0) {
        unsigned* bar = b.bar;
        __builtin_amdgcn_s_waitcnt(0);
        unsigned nloc = b.st[0], nx = b.st[1];
        if (nloc == 0u) { xcd_barrier_complete(bar, b.x, nloc, nx); b.st[0] = nloc; b.st[1] = nx; }
        const unsigned old = xb_add(&bar[XB_XSUB(b.x)], 1u);
        const unsigned gen = old / nloc;
        if (old + 1u == (gen + 1u) * nloc) {
            __builtin_amdgcn_fence(__ATOMIC_RELEASE, "agent");
            asm volatile("s_waitcnt vmcnt(0)" ::: "memory");
            const unsigned og = xb_add(&bar[XB_TOP], 1u);
            const unsigned tg = og / nx;
            if (og + 1u == (tg + 1u) * nx) xb_add(&bar[XB_TOPGEN], 1u);
            else XB_SPIN(xb_ld(&bar[XB_TOPGEN]) == tg, bar);
            __builtin_amdgcn_fence(__ATOMIC_ACQUIRE, "agent");
            xb_add(&bar[XB_XGEN(b.x)], 1u);
            asm volatile("s_waitcnt vmcnt(0)" ::: "memory");
        } else {
            XB_SPIN(xb_ld(&bar[XB_XGEN(b.x)]) == gen, bar);
            __builtin_amdgcn_fence(__ATOMIC_ACQUIRE, "agent");
            asm volatile("s_waitcnt vmcnt(0)" ::: "memory");
        }
    }
    __syncthreads();
}


#ifndef SK0
#define SK0 0
#endif
#ifndef SK1
#define SK1 0
#endif
#ifndef SK2
#define SK2 0
#endif
#ifndef SK3
#define SK3 0
#endif
#ifndef SK4
#define SK4 0
#endif
#ifndef SK5
#define SK5 0
#endif
#ifndef SK6
#define SK6 0
#endif
#ifndef SKP
#define SKP 0
#endif
#ifndef REPMASK
#define REPMASK 0
#endif
#ifndef REPK1SEL
#define REPK1SEL 0
#endif
#ifndef REPSYNC
#define REPSYNC 0
#endif
#ifndef REPPRO
#define REPPRO 0
#endif
constexpr int PT_OFF = 131072 + 4096, MISC_OFF = 131072 + 8192;
__device__ __forceinline__ unsigned char* rd_ptr(int i) {
    const unsigned long long v = *(const LAS unsigned long long*)(((LAS unsigned char*)0) + PT_OFF + 8 * i);
    const unsigned lo = __builtin_amdgcn_readfirstlane((unsigned)v), hi = __builtin_amdgcn_readfirstlane((unsigned)(v >> 32));
    typedef __attribute__((address_space(1))) unsigned char gbyte;
    gbyte* gp = (gbyte*)(((unsigned long long)hi << 32) | lo);
    return (unsigned char*)gp;
}
__device__ __forceinline__ unsigned char* rd_ptr_generic(int i) {
    const unsigned long long v = *(const LAS unsigned long long*)(((LAS unsigned char*)0) + PT_OFF + 8 * i);
    const unsigned lo = __builtin_amdgcn_readfirstlane((unsigned)v), hi = __builtin_amdgcn_readfirstlane((unsigned)(v >> 32));
    return (unsigned char*)(((unsigned long long)hi << 32) | lo);
}
#define P_IN(i) ((const float*)rd_ptr(i))
#define P_OUT() ((float*)rd_ptr(23))
#define P_WS() (rd_ptr(24))

__global__ void __launch_bounds__(NTHR, 2) trunk_fwd(Args args) {
    extern __shared__ __attribute__((aligned(16))) unsigned char lds_raw[];
    cg::grid_group grid = cg::this_grid();
    LAS unsigned char* lds = (LAS unsigned char*)lds_raw;
    {
        const int tid = threadIdx.x;
        LAS unsigned long long* PT = (LAS unsigned long long*)(lds + PT_OFF);
        if (tid < 23) PT[tid] = (unsigned long long)args.in[tid];
        if (tid == 23) PT[23] = (unsigned long long)args.out;
        if (tid == 24) PT[24] = (unsigned long long)args.ws;
        if (tid < 16) ((LAS unsigned*)(lds + MISC_OFF))[tid] = 0u;
        __syncthreads();
        (void)xcd_barrier_post((unsigned*)(args.ws + WS_BAR), (volatile LAS unsigned*)(lds + MISC_OFF));
        const int lane = tid & 63, wave = __builtin_amdgcn_readfirstlane(tid >> 6);
        for (int rp_ = 0; rp_ < (REPPRO ? 2 : 1); ++rp_)
        if (!SKP) prologue(args, args.ws, lds, (int)blockIdx.x * NWAVES + wave, (int)gridDim.x * NWAVES, wave, lane);
    }
    grid.sync();

    constexpr int NREP = (REPMASK || REPSYNC) ? 2 : 1;
    for (int it_ = 0; it_ < 32 * NREP; ++it_) {
        const int st = it_ / NREP, rep_ = it_ % NREP;
        const int l = st >> 4, s = st & 15;
        int kind, hb = 0;
        if (s == 0 || s == 14) kind = 0; else if (s == 1 || s == 15) kind = 1; else { hb = (s - 2) / 6; kind = 2 + (s - 2) % 6; if (kind == 7) kind = 1; }
        const size_t hrow = (size_t)hb * MH;
        int G = gridDim.x, bx = blockIdx.x; asm volatile("" : "+s"(G), "+s"(bx));
        unsigned char* ws = P_WS();
        unsigned char* wl = ws + WS_W + (size_t)l * W_LSTRIDE;
        if (rep_ == 1 && !(((REPMASK >> kind) & 1) || REPSYNC)) continue;
        if (rep_ == 1 && kind == 1 && REPK1SEL && ((REPK1SEL == 1) != (s == 1 || s == 15))) continue;
        if (!(rep_ == 1 && REPSYNC)) {
        if (kind == 0 && !SK0) {
            pg8::Gemm g{(const u16*)(ws + WS_XB), (const u16*)(wl + (s == 0 ? WO_13A : WO_13B)), MROWS, 2 * FF, DM}; pg8::StaticOrder S; S.init(MROWS, 2 * FF, G, bx);
            pg8::EpiSwiglu E{(u16*)(ws + WS_ZA), (const float*)(ws + WS_SSP)};
            pg8::gemm_phase<pg8::EpiSwiglu, pg8::StaticOrder, PG8_ALIGN, PG8_SP2>(lds, g, S, E);
        } else if (kind == 1 && !SK1) {
            const bool ffn = (s == 1 || s == 15);
            const u16* Aop = (const u16*)(ws + (ffn ? WS_ZA : WS_MG)); const u16* Bop = (const u16*)(wl + (s == 1 ? WO_2A : (s == 15 ? WO_2B : WO_OUT)));
            const int Mr = ffn ? MROWS : MH, K = ffn ? FF : DM;
            const float* x0 = nullptr;
            pg8::Gemm g{Aop, Bop, Mr, DM, K}; pg8::StaticOrder S; S.init(Mr, DM, G, bx);
            pg8::EpiResid E{x0, (u16*)(ws + WS_XB) + hrow * DM, (float*)(ws + WS_SSP) + hrow * 16, rep_ ? 0.0f : (ffn ? 0.5f : 1.0f)};
            pg8::gemm_phase<pg8::EpiResid, pg8::StaticOrder, PG8_ALIGN, PG8_SP2>(lds, g, S, E);
        } else if (kind == 2 && !SK2) {
            pg8::Gemm g{(const u16*)(ws + WS_XB) + hrow * DM, (const u16*)(wl + WO_IN), MH, 24 * 256, DM}; pg8::StaticOrder S; S.init(MH, 24 * 256, G, bx);
            pg8::EpiWin E{(u16*)(ws + WS_ZA), (u16*)(ws + WS_QC), (u16*)(ws + WS_KC), (u16*)(ws + WS_VC), (float*)(ws + WS_MIF), (const float*)(ws + WS_SSP) + hrow * 16, (const float*)(ws + WS_COS) + hrow * 32, (const float*)(ws + WS_SIN) + hrow * 32, P_IN(11) + l * 8};
            pg8::gemm_phase<pg8::EpiWin, pg8::StaticOrder, PG8_ALIGN, PG8_SP2>(lds, g, S, E);
        } else if (kind == 3 && !SK3) {
            int tid = threadIdx.x; asm volatile("" : "+v"(tid));
            stage_conv_weights(P_IN(9) + l * 4 * 512, P_IN(10) + l * 512, lds, tid);
            { const u16* Zp = (const u16*)(ws + WS_ZA); const float* mifp = (const float*)(ws + WS_MIF);
              if (bx < 1024) { M1In cur = m1_load(Zp, mifp, bx, tid);
                for (int un = bx; un < 1024; un += G) { const M1In nxt = m1_load(Zp, mifp, un + G < 1024 ? un + G : un, tid);
                    m1_compute(cur, (float*)(ws + WS_U), (float*)(ws + WS_NU), (float*)(ws + WS_ML), (float*)(ws + WS_BL), lds, un, tid);
                    cur = nxt; } } }
            { const u16* Zp = (const u16*)(ws + WS_ZA); const float* pw = P_IN(7) + l * 4 * 4096; const float* psc = P_IN(8) + l * 256;
              if (bx < 1024) { PoolIn cur = pool_load(Zp, pw, bx, tid);
                for (int un = bx; un < 1024; un += G) { const PoolIn nxt = pool_load(Zp, pw, un + G < 1024 ? un + G : un, tid);
                    pool_compute(cur, (u16*)(ws + WS_YA), psc, lds, un, tid);
                    cur = nxt; } } }
        } else if (kind == 4 && !SK4) {
            { int tid = threadIdx.x; asm volatile("" : "+v"(tid));
              m2_phase((const float*)(ws + WS_U), (const float*)(ws + WS_NU), (const float*)(ws + WS_ML), (const float*)(ws + WS_BL), (u16*)(ws + WS_CST), (float*)(ws + WS_NST), (float*)(ws + WS_MST), lds, G, bx, tid); }
            unsigned char* wsg = rd_ptr_generic(24);
            const int rounds = (512 + G - 1) / G;
            for (int r = 0; r < rounds; ++r) {
                const int p = (r & 1) ? (G - 1 - bx) : bx; const int u = r * G + p;
                if (u < 512) { const int qb = 15 - (u >> 5), pair = u & 31, bl = pair >> 3, j = pair & 7;
                    attn_body::attn_unit<8>(qb, (const attn_body::bf16*)((const u16*)(wsg + WS_QC) + (size_t)(bl * 8 + j) * SEQ * 64), (const attn_body::bf16*)((const u16*)(wsg + WS_KC) + (size_t)(bl * 8 + j) * SEQ * 64),
                                            (const attn_body::bf16*)((const u16*)(wsg + WS_VC) + (size_t)((bl * 4 + (j >> 1)) * 2) * SEQ * 64),
                                            (attn_body::bf16*)((u16*)(wsg + WS_O) + (size_t)(bl * SEQ) * 1024 + j * 128), (char*)lds_raw); }
            }
        } else if (kind == 5 && !SK5) {
            int tid = threadIdx.x; asm volatile("" : "+v"(tid));
            stage_conv_weights(P_IN(9) + l * 4 * 512, P_IN(10) + l * 512, lds, tid);
            { const u16* Zp = (const u16*)(ws + WS_ZA); const float* mifp = (const float*)(ws + WS_MIF); const u16* cstp = (const u16*)(ws + WS_CST); const float* nstp = (const float*)(ws + WS_NST); const float* mstp = (const float*)(ws + WS_MST);
              if (bx < 1024) { M3In cur = m3_load(Zp, mifp, cstp, nstp, mstp, bx, tid);
                for (int un = bx; un < 1024; un += G) { const M3In nxt = m3_load(Zp, mifp, cstp, nstp, mstp, un + G < 1024 ? un + G : un, tid);
                    m3_compute(cur, P_IN(12) + l * 256, (u16*)(ws + WS_YB), lds, un, tid);
                    cur = nxt; } } }
            const float lambda_init = 0.8f - 0.6f * expf(-0.3f * (float)l);
            attn_post((const u16*)(ws + WS_O), (u16*)(ws + WS_YC), P_IN(13) + l * 256, P_IN(14) + l * 128, lambda_init, bx * NTHR + tid, G * NTHR, tid & 63);
        } else if (!SK6) {
            pg8::Gemm g{(const u16*)(ws + WS_YA), (const u16*)(wl + WO_PA), 4 * MH, 4 * DM, 256}; pg8::MergeOrder S; S.init(MH, DM, G, bx);
            pg8::EpiMerge E{(const u16*)(ws + WS_ZA), (u16*)(ws + WS_MG)};
            pg8::gemm_phase<pg8::EpiMerge, pg8::MergeOrder, PG8_ALIGN, PG8_SP2>(lds, g, S, E);
        }
        }
        { XcdBarrier bar; bar.bar = (unsigned*)(P_WS() + WS_BAR); bar.x = xb_xcc_id(); bar.st = (volatile LAS unsigned*)(lds + MISC_OFF); xcd_barrier(bar); }
    }
    { const float* fg = P_IN(22); float* outp = P_OUT(); const u16* xb = (const u16*)(P_WS() + WS_XB);
      int tid = threadIdx.x; asm volatile("" : "+v"(tid)); const int lane = tid & 63, gw = (int)blockIdx.x * NWAVES + (tid >> 6), NGW = (int)gridDim.x * NWAVES;
      v4f gg[4];
#pragma unroll
      for (int j = 0; j < 4; ++j) gg[j] = *((const v4f*)(fg + 16 * lane) + j);
      for (int row0 = gw; row0 < MROWS; row0 += 4 * NGW) {
        v4u ra[4], rb[4];
#pragma unroll
        for (int k = 0; k < 4; ++k) { const int row = row0 + k * NGW < MROWS ? row0 + k * NGW : row0; const u16* xr = xb + tl(row, 16 * lane, DM); ra[k] = *(const v4u*)xr; rb[k] = *(const v4u*)(xr + 8); }
        asm volatile("" ::: "memory");
#pragma unroll
        for (int k = 0; k < 4; ++k) { const int row = row0 + k * NGW; if (row < MROWS) { float x[16]; float sq = 0.f;
            unpack8(ra[k], x); unpack8(rb[k], x + 8);
#pragma unroll
            for (int i = 0; i < 16; ++i) sq += x[i] * x[i];
            const float rs = rsqrtf(wave_sum(sq, lane) * (1.0f / DM) + EPS);
            v4f* op = (v4f*)(outp + (size_t)row * DM + 16 * lane);
#pragma unroll
            for (int j = 0; j < 4; ++j) op[j] = (v4f){x[4 * j] * rs * gg[j].x, x[4 * j + 1] * rs * gg[j].y, x[4 * j + 2] * rs * gg[j].z, x[4 * j + 3] * rs * gg[j].w}; } }
      } }
}

extern "C" void kernel_launch(void* const* d_in, const int* in_sizes, int n_in, void* d_out, int out_size, void* d_ws, size_t ws_size, hipStream_t stream) {
    static int grid = 0;
    if (grid == 0) {
        if (n_in != 23 || in_sizes[0] != MROWS * DM || out_size != MROWS * DM || ws_size < WS_END) { fprintf(stderr, "kernel_launch: unexpected shapes / workspace (n_in %d, ws %zu)\n", n_in, ws_size); grid = -1; return; }
        int dev = 0, cus = 0, per_cu = 0;
        hipGetDevice(&dev); hipDeviceGetAttribute(&cus, hipDeviceAttributeMultiprocessorCount, dev);
        hipFuncSetAttribute((const void*)trunk_fwd, hipFuncAttributeMaxDynamicSharedMemorySize, LDS_BYTES);
        hipOccupancyMaxActiveBlocksPerMultiprocessor(&per_cu, (const void*)trunk_fwd, NTHR, LDS_BYTES);
        (void)hipGetLastError();
        if (per_cu < 1) per_cu = 1;
        grid = cus * 1;
        if (grid <= 0) grid = 256;
    }
    if (grid < 0) return;
    if (hipMemsetAsync((char*)d_ws + WS_BAR, 0, CTL_ZERO_BYTES, stream) != hipSuccess) { fprintf(stderr, "kernel_launch: hipMemsetAsync failed\n"); return; }
    Args a{};
    for (int i = 0; i < 23; ++i) a.in[i] = d_in[i];
    a.out = (float*)d_out; a.ws = (unsigned char*)d_ws;
    void* kargs[] = {&a};
    hipError_t e = hipLaunchCooperativeKernel((const void*)trunk_fwd, dim3(grid), dim3(NTHR), kargs, LDS_BYTES, stream);
    if (e != hipSuccess) fprintf(stderr, "cooperative launch failed: %s (grid %d)\n", hipGetErrorString(e), grid);
}
```
